# Optimizing an MI355X kernel written in HIP

```python
import numpy as np
import jax
import jax.numpy as jnp
from jax import lax

D_MODEL = 2048
BATCH = 8
SEQ = 2048
DEPTH = 1

HEAD_DIM = 128
N_HEADS = D_MODEL // HEAD_DIM
MOBA_HEADS = N_HEADS // 2
NSA_HEADS = N_HEADS - MOBA_HEADS
NSA_KV_GROUPS = 2
NSA_REP = NSA_HEADS // NSA_KV_GROUPS
MOBA_WIDTH = MOBA_HEADS * HEAD_DIM
NSA_WIDTH = NSA_HEADS * HEAD_DIM
NSA_KV_WIDTH = NSA_KV_GROUPS * HEAD_DIM
NSA_N_GATES = 3 * NSA_HEADS
IN_COLS = 4 * MOBA_WIDTH + 2 * NSA_WIDTH + 6 * NSA_KV_WIDTH + NSA_N_GATES
MOBA_BLOCK = 256
MOBA_TOPK = 3
MOBA_Q_CHUNK = 32
CMP_BLOCK = 32
CMP_STRIDE = 16
CMP_HIDDEN = 2 * HEAD_DIM
SEL_BLOCK = 64
SEL_TOPK = 8
WINDOW = 512
NSA_Q_CHUNK = 64
ROPE_THETA = 10000.0
EPS = 1e-6

kernel_name = 'hybrid_moba_nsa_layer'


def _split_points():
    sizes = [MOBA_WIDTH] * 4 + [NSA_WIDTH] + [NSA_KV_WIDTH] * 6 + [NSA_N_GATES, NSA_WIDTH]
    return [int(v) for v in np.cumsum(sizes)[:-1]]


def rmsnorm(x, g):
    xf = x.astype(jnp.float32)
    y = xf * lax.rsqrt(jnp.mean(xf * xf, axis=-1, keepdims=True) + EPS)
    return (y * g.astype(jnp.float32)).astype(x.dtype)


def rope_tables(positions):
    inv_freq = 1.0 / (ROPE_THETA ** (jnp.arange(0, HEAD_DIM, 2, dtype=jnp.float32) / HEAD_DIM))
    ang = positions.astype(jnp.float32)[..., None] * inv_freq
    return jnp.cos(ang), jnp.sin(ang)


def apply_rope(x, cos, sin):
    c = cos[:, :, None, :]
    s = sin[:, :, None, :]
    x1, x2 = jnp.split(x.astype(jnp.float32), 2, axis=-1)
    return jnp.concatenate([x1 * c - x2 * s, x2 * c + x1 * s], axis=-1).astype(x.dtype)


def masked_softmax(s, mask):
    s = jnp.where(mask, s, -jnp.inf)
    m = jnp.max(s, axis=-1, keepdims=True)
    m = jnp.where(jnp.isfinite(m), m, 0.0)
    e = jnp.where(mask, jnp.exp(s - m), 0.0)
    return e / jnp.maximum(jnp.sum(e, axis=-1, keepdims=True), 1e-30)


def moba_attention(q, k, v):
    B, H, S, dh = q.shape
    n_blk = -(-S // MOBA_BLOCK)
    pad = n_blk * MOBA_BLOCK - S
    kp = jnp.pad(k, ((0, 0), (0, 0), (0, pad), (0, 0)))
    vp = jnp.pad(v, ((0, 0), (0, 0), (0, pad), (0, 0)))
    kb = kp.reshape(B, H, n_blk, MOBA_BLOCK, dh)
    vb = vp.reshape(B, H, n_blk, MOBA_BLOCK, dh)
    k_mean = jnp.mean(kb.astype(jnp.float32), axis=3)
    k_top = min(MOBA_TOPK, n_blk - 1)
    scale = dh ** -0.5
    b_ix = jnp.arange(B)[:, None, None, None]
    h_ix = jnp.arange(H)[None, :, None, None]
    blk_ix = jnp.arange(n_blk)
    C = MOBA_Q_CHUNK

    def chunk(c0):
        qc = lax.dynamic_slice_in_dim(q, c0, C, axis=2)
        q_pos = c0 + jnp.arange(C)
        own = c0 // MOBA_BLOCK
        k_own = lax.dynamic_slice_in_dim(kp, own * MOBA_BLOCK, MOBA_BLOCK, axis=2)
        v_own = lax.dynamic_slice_in_dim(vp, own * MOBA_BLOCK, MOBA_BLOCK, axis=2)
        own_pos = own * MOBA_BLOCK + jnp.arange(MOBA_BLOCK)
        s_own = jnp.einsum('bhqd,bhkd->bhqk', qc, k_own).astype(jnp.float32) * scale
        m_own = jnp.broadcast_to(own_pos[None, :] <= q_pos[:, None], s_own.shape)
        if k_top == 0:
            p = masked_softmax(s_own, m_own).astype(v.dtype)
            return jnp.einsum('bhqk,bhkd->bhqd', p, v_own)
        gate = jnp.einsum('bhqd,bhnd->bhqn', qc.astype(jnp.float32), k_mean)
        fully_past = (blk_ix[None, :] + 1) * MOBA_BLOCK <= q_pos[:, None]
        gate = jnp.where(fully_past, gate, -jnp.inf)
        g_val, g_idx = lax.top_k(gate, k_top)
        k_sel = kb[b_ix, h_ix, g_idx]
        v_sel = vb[b_ix, h_ix, g_idx]
        s_sel = jnp.einsum('bhqd,bhqnld->bhqnl', qc, k_sel).astype(jnp.float32) * scale
        m_sel = jnp.broadcast_to(jnp.isfinite(g_val)[..., None], s_sel.shape)
        n_sel = k_top * MOBA_BLOCK
        s_all = jnp.concatenate([s_sel.reshape(B, H, C, n_sel), s_own], axis=-1)
        m_all = jnp.concatenate([m_sel.reshape(B, H, C, n_sel), m_own], axis=-1)
        p = masked_softmax(s_all, m_all).astype(v.dtype)
        p_sel = p[..., :n_sel].reshape(B, H, C, k_top, MOBA_BLOCK)
        return (jnp.einsum('bhqnl,bhqnld->bhqd', p_sel, v_sel)
                + jnp.einsum('bhqk,bhkd->bhqd', p[..., n_sel:], v_own))

    out = lax.map(chunk, jnp.arange(S // C) * C)
    return out.transpose(1, 2, 0, 3, 4).reshape(B, H, S, dh)


def compress_tokens(kv, pe, w1, w2):
    B, S, G, dh = kv.shape
    n_seg = S // CMP_STRIDE
    r = CMP_BLOCK // CMP_STRIDE
    n_cmp = n_seg - r + 1
    seg = kv.reshape(B, n_seg, CMP_STRIDE, G, dh)
    blocks = jnp.concatenate([seg[:, i:i + n_cmp] for i in range(r)], axis=2)
    blocks = blocks + pe[None, None, :, None, :]
    flat = blocks.transpose(0, 3, 1, 2, 4).reshape(B, G, n_cmp, CMP_BLOCK * dh)
    return jax.nn.silu(flat @ w1) @ w2


def cmp_to_sel_overlap(n_cmp, n_sel_blk):
    cs = np.arange(n_cmp)[:, None] * CMP_STRIDE
    ss = np.arange(n_sel_blk)[None, :] * SEL_BLOCK
    ov = (cs < ss + SEL_BLOCK) & (cs + CMP_BLOCK > ss)
    return jnp.asarray(ov.astype(np.float32))


def nsa_attention(q_rot, q_raw, k_c, v_c, k_s, v_s, k_w, v_w, gates):
    B, G, R, S, dh = q_rot.shape
    scale = dh ** -0.5
    pos = jnp.arange(S)
    n_cmp = k_c.shape[2]
    s_c = jnp.einsum('bgrqd,bgnd->bgrqn', q_raw, k_c).astype(jnp.float32) * scale
    cmp_end = jnp.arange(n_cmp) * CMP_STRIDE + CMP_BLOCK - 1
    p_c = masked_softmax(s_c, cmp_end[None, :] <= pos[:, None])
    o_c = jnp.einsum('bgrqn,bgnd->bgrqd', p_c.astype(v_c.dtype), v_c)
    n_blk = S // SEL_BLOCK
    imp = jnp.einsum('bgrqn,nj->bgqj', p_c, cmp_to_sel_overlap(n_cmp, n_blk))
    blk = jnp.arange(n_blk)[None, :]
    own = (pos // SEL_BLOCK)[:, None]
    forced = (blk == 0) | (blk == own) | (blk == own - 1)
    future = blk * SEL_BLOCK > pos[:, None]
    score = jnp.where(future, -jnp.inf, jnp.where(forced, jnp.inf, imp))
    n_top = min(SEL_TOPK, n_blk)
    s_val, s_idx = lax.top_k(score, n_top)
    s_ok = s_val > -jnp.inf
    ksb = k_s.reshape(B, G, n_blk, SEL_BLOCK, dh)
    vsb = v_s.reshape(B, G, n_blk, SEL_BLOCK, dh)
    kwp = jnp.pad(k_w, ((0, 0), (0, 0), (WINDOW, 0), (0, 0)))
    vwp = jnp.pad(v_w, ((0, 0), (0, 0), (WINDOW, 0), (0, 0)))
    b_ix = jnp.arange(B)[:, None, None, None]
    g_ix = jnp.arange(G)[None, :, None, None]
    C = NSA_Q_CHUNK
    n_keys = n_top * SEL_BLOCK

    def chunk(c0):
        qc = lax.dynamic_slice_in_dim(q_rot, c0, C, axis=3)
        q_pos = c0 + jnp.arange(C)
        idx = lax.dynamic_slice_in_dim(s_idx, c0, C, axis=2)
        ok = lax.dynamic_slice_in_dim(s_ok, c0, C, axis=2)
        k_sel = ksb[b_ix, g_ix, idx]
        v_sel = vsb[b_ix, g_ix, idx]
        s_s = jnp.einsum('bgrqd,bgqnld->bgrqnl', qc, k_sel).astype(jnp.float32) * scale
        key_pos = idx[..., None] * SEL_BLOCK + jnp.arange(SEL_BLOCK)
        m_s = ok[..., None] & (key_pos <= q_pos[None, None, :, None, None])
        p_s = masked_softmax(s_s.reshape(B, G, R, C, n_keys), m_s.reshape(B, G, 1, C, n_keys))
        p_s = p_s.reshape(B, G, R, C, n_top, SEL_BLOCK).astype(v_s.dtype)
        o_s = jnp.einsum('bgrqnl,bgqnld->bgrqd', p_s, v_sel)
        k_win = lax.dynamic_slice_in_dim(kwp, c0, WINDOW + C, axis=2)
        v_win = lax.dynamic_slice_in_dim(vwp, c0, WINDOW + C, axis=2)
        w_pos = c0 - WINDOW + jnp.arange(WINDOW + C)
        m_w = ((w_pos[None, :] <= q_pos[:, None]) & (w_pos[None, :] > q_pos[:, None] - WINDOW)
               & (w_pos[None, :] >= 0))
        s_w = jnp.einsum('bgrqd,bgkd->bgrqk', qc, k_win).astype(jnp.float32) * scale
        p_w = masked_softmax(s_w, m_w).astype(v_w.dtype)
        o_w = jnp.einsum('bgrqk,bgkd->bgrqd', p_w, v_win)
        return o_s, o_w

    o_s, o_w = lax.map(chunk, jnp.arange(S // C) * C)
    o_s = o_s.transpose(1, 2, 3, 0, 4, 5).reshape(B, G, R, S, dh)
    o_w = o_w.transpose(1, 2, 3, 0, 4, 5).reshape(B, G, R, S, dh)
    return gates[..., 0:1] * o_c + gates[..., 1:2] * o_s + gates[..., 2:3] * o_w


def hybrid_layer(x, cos, sin, w_in, g_norm, pe_ck, pe_cv, w_ck1, w_ck2, w_cv1, w_cv2,
                 g_out_moba, g_out_nsa, w_out):
    B, S, _ = x.shape
    G = NSA_KV_GROUPS
    h = rmsnorm(x, g_norm)
    proj = jnp.einsum('bsd,de->bse', h, w_in)
    (m_q, m_k, m_v, m_z, n_q, n_kc, n_vc, n_ks, n_vs, n_kw, n_vw, n_g, n_z) = jnp.split(
        proj, _split_points(), axis=-1)
    mq = apply_rope(m_q.reshape(B, S, MOBA_HEADS, HEAD_DIM), cos, sin).transpose(0, 2, 1, 3)
    mk = apply_rope(m_k.reshape(B, S, MOBA_HEADS, HEAD_DIM), cos, sin).transpose(0, 2, 1, 3)
    mv = m_v.reshape(B, S, MOBA_HEADS, HEAD_DIM).transpose(0, 2, 1, 3)
    o_moba = moba_attention(mq, mk, mv).transpose(0, 2, 1, 3).reshape(B, S, MOBA_WIDTH)
    y_moba = rmsnorm(o_moba * jax.nn.silu(m_z), g_out_moba)
    nq = n_q.reshape(B, S, NSA_HEADS, HEAD_DIM)
    q_rot = apply_rope(nq, cos, sin).reshape(B, S, G, NSA_REP, HEAD_DIM).transpose(0, 2, 3, 1, 4)
    q_raw = nq.reshape(B, S, G, NSA_REP, HEAD_DIM).transpose(0, 2, 3, 1, 4)
    k_c = compress_tokens(n_kc.reshape(B, S, G, HEAD_DIM), pe_ck, w_ck1, w_ck2)
    v_c = compress_tokens(n_vc.reshape(B, S, G, HEAD_DIM), pe_cv, w_cv1, w_cv2)
    k_s = apply_rope(n_ks.reshape(B, S, G, HEAD_DIM), cos, sin).transpose(0, 2, 1, 3)
    v_s = n_vs.reshape(B, S, G, HEAD_DIM).transpose(0, 2, 1, 3)
    k_w = apply_rope(n_kw.reshape(B, S, G, HEAD_DIM), cos, sin).transpose(0, 2, 1, 3)
    v_w = n_vw.reshape(B, S, G, HEAD_DIM).transpose(0, 2, 1, 3)
    gates = jax.nn.sigmoid(n_g.reshape(B, S, G, NSA_REP, 3)).transpose(0, 2, 3, 1, 4)
    o_nsa = nsa_attention(q_rot, q_raw, k_c, v_c, k_s, v_s, k_w, v_w, gates)
    o_nsa = o_nsa.transpose(0, 3, 1, 2, 4).reshape(B, S, NSA_WIDTH)
    y_nsa = rmsnorm(o_nsa * jax.nn.silu(n_z), g_out_nsa)
    y = jnp.concatenate([y_moba, y_nsa], axis=-1)
    return x + jnp.einsum('bse,ed->bsd', y, w_out)


def setup_inputs(seed: int = 0) -> dict:
    key = jax.random.key(seed)
    ks = jax.random.split(key, 13)
    f32 = jnp.float32

    def nrm(k, shape, fan_in):
        return jax.random.normal(k, shape, f32) * (fan_in ** -0.5)

    x = jax.random.normal(ks[0], (BATCH, SEQ, D_MODEL), f32)
    positions = jnp.broadcast_to(jnp.arange(SEQ, dtype=jnp.int32)[None, :], (BATCH, SEQ))
    w_in = nrm(ks[1], (DEPTH, D_MODEL, IN_COLS), D_MODEL)
    g_norm = 1.0 + 0.01 * jax.random.normal(ks[2], (DEPTH, D_MODEL), f32)
    pe_ck = 0.1 * jax.random.normal(ks[3], (DEPTH, CMP_BLOCK, HEAD_DIM), f32)
    pe_cv = 0.1 * jax.random.normal(ks[4], (DEPTH, CMP_BLOCK, HEAD_DIM), f32)
    w_ck1 = nrm(ks[5], (DEPTH, CMP_BLOCK * HEAD_DIM, CMP_HIDDEN), CMP_BLOCK * HEAD_DIM)
    w_ck2 = nrm(ks[6], (DEPTH, CMP_HIDDEN, HEAD_DIM), CMP_HIDDEN)
    w_cv1 = nrm(ks[7], (DEPTH, CMP_BLOCK * HEAD_DIM, CMP_HIDDEN), CMP_BLOCK * HEAD_DIM)
    w_cv2 = nrm(ks[8], (DEPTH, CMP_HIDDEN, HEAD_DIM), CMP_HIDDEN)
    g_out_moba = 1.0 + 0.01 * jax.random.normal(ks[9], (DEPTH, MOBA_WIDTH), f32)
    g_out_nsa = 1.0 + 0.01 * jax.random.normal(ks[10], (DEPTH, NSA_WIDTH), f32)
    w_out = nrm(ks[11], (DEPTH, D_MODEL, D_MODEL), D_MODEL)
    g_final = 1.0 + 0.01 * jax.random.normal(ks[12], (D_MODEL,), f32)
    return {'x': x, 'positions': positions, 'w_in': w_in, 'g_norm': g_norm,
            'pe_ck': pe_ck, 'pe_cv': pe_cv, 'w_ck1': w_ck1, 'w_ck2': w_ck2,
            'w_cv1': w_cv1, 'w_cv2': w_cv2, 'g_out_moba': g_out_moba,
            'g_out_nsa': g_out_nsa, 'w_out': w_out, 'g_final': g_final}


def reference(x, positions, w_in, g_norm, pe_ck, pe_cv, w_ck1, w_ck2, w_cv1, w_cv2,
              g_out_moba, g_out_nsa, w_out, g_final):
    cos, sin = rope_tables(positions)
    for layer in range(DEPTH):
        x = hybrid_layer(x, cos, sin, w_in[layer], g_norm[layer], pe_ck[layer], pe_cv[layer],
                         w_ck1[layer], w_ck2[layer], w_cv1[layer], w_cv2[layer],
                         g_out_moba[layer], g_out_nsa[layer], w_out[layer])
    return rmsnorm(x, g_final)
```

```cpp
#include <hip/hip_runtime.h>
#include <cstdio>
#include <cstdint>

constexpr int NB = 8, SEQ = 2048, DM = 2048, M = NB * SEQ;
constexpr int HD = 128;
constexpr int INC = 7704;
constexpr int C_NG = 6656, C_NZ = 6680;
constexpr float EPS = 1e-6f;
constexpr float SCALE = 0.08838834764831845f;
constexpr int NPAD = 7936;

typedef unsigned short bf16;
typedef short bf16x8 __attribute__((ext_vector_type(8)));
typedef float f32x4 __attribute__((ext_vector_type(4)));
typedef float f32x16 __attribute__((ext_vector_type(16)));
typedef unsigned u32x4 __attribute__((ext_vector_type(4)));
typedef unsigned u32x2 __attribute__((ext_vector_type(2)));

__device__ __forceinline__ unsigned f2bf(float f) { unsigned u = __builtin_bit_cast(unsigned, f); return (u + 0x7fffu + ((u >> 16) & 1u)) >> 16; }
__device__ __forceinline__ unsigned pk2(float lo, float hi) { return f2bf(lo) | (f2bf(hi) << 16); }
__device__ __forceinline__ float bf2f(unsigned b) { return __builtin_bit_cast(float, b << 16); }
__device__ __forceinline__ float silu_f(float v) { return v / (1.f + __expf(-v)); }
__device__ __forceinline__ float sigmoid_f(float v) { return 1.f / (1.f + __expf(-v)); }
__device__ __forceinline__ float wave_sum(float v) {
#pragma unroll
    for (int o = 1; o < 64; o <<= 1) v += __shfl_xor(v, o);
    return v;
}
__device__ __forceinline__ float wave_max(float v) {
#pragma unroll
    for (int o = 1; o < 64; o <<= 1) v = fmaxf(v, __shfl_xor(v, o));
    return v;
}

constexpr size_t MiB = 1u << 20;
constexpr size_t WS_CTL = 0, CTL_ZERO_BYTES = 1 * MiB;
constexpr size_t WS_KMS = 512 * 1024;
constexpr size_t WS_WINT = 2 * MiB;
constexpr size_t WS_WOUTT = 34 * MiB;
constexpr size_t WS_WC1T = 42 * MiB;
constexpr size_t WS_WC2T = 46 * MiB;
constexpr size_t WS_CBIAS = 46 * MiB + 256 * 1024;
constexpr size_t WS_KC = 46 * MiB + 512 * 1024;
constexpr size_t WS_VC = 47 * MiB;
constexpr size_t WS_GATES = 48 * MiB;
constexpr size_t WS_COS = 54 * MiB, WS_SIN = 58 * MiB;
constexpr size_t WS_H = 64 * MiB;
constexpr size_t WS_T = WS_H;
constexpr size_t WS_QM = 128 * MiB, WS_KM = 160 * MiB, WS_VM = 192 * MiB;
constexpr size_t WS_GZ = 224 * MiB;
constexpr size_t WS_NQROT = 288 * MiB, WS_NQRAW = 320 * MiB;
constexpr size_t WS_KCIN = 352 * MiB, WS_VCIN = 360 * MiB, WS_KS = 368 * MiB, WS_VS = 376 * MiB, WS_KW = 384 * MiB, WS_VW = 392 * MiB;
constexpr size_t WS_END = 400 * MiB;

struct Bufs {
    const float* x; const int* pos; const float *w_in, *g_norm, *pe_ck, *pe_cv, *w_ck1, *w_ck2, *w_cv1, *w_cv2, *g_out_moba, *g_out_nsa, *w_out, *g_final;
    float* out; unsigned char* ws;
    __device__ __forceinline__ bf16* b16(size_t off) const { return (bf16*)(ws + off); }
    __device__ __forceinline__ float* f32(size_t off) const { return (float*)(ws + off); }
};

__device__ const float INV_FREQ[64] = {
    1.000000000e+00f, 8.659643531e-01f, 7.498942018e-01f, 6.493816376e-01f, 5.623413324e-01f, 4.869675338e-01f, 4.216965139e-01f, 3.651741147e-01f, 3.162277639e-01f, 2.738419771e-01f, 2.371373922e-01f, 2.053525001e-01f, 1.778279394e-01f, 1.539926529e-01f, 1.333521456e-01f, 1.154782027e-01f,
    1.000000015e-01f, 8.659642935e-02f, 7.498941571e-02f, 6.493816525e-02f, 5.623412877e-02f, 4.869675264e-02f, 4.216964915e-02f, 3.651741147e-02f, 3.162277862e-02f, 2.738419734e-02f, 2.371373586e-02f, 2.053524926e-02f, 1.778279431e-02f, 1.539926510e-02f, 1.333521493e-02f, 1.154781971e-02f,
    9.999999776e-03f, 8.659643121e-03f, 7.498942316e-03f, 6.493816618e-03f, 5.623413250e-03f, 4.869675264e-03f, 4.216964822e-03f, 3.651741426e-03f, 3.162277862e-03f, 2.738419687e-03f, 2.371373819e-03f, 2.053525066e-03f, 1.778279431e-03f, 1.539926627e-03f, 1.333521446e-03f, 1.154781901e-03f,
    1.000000047e-03f, 8.659643354e-04f, 7.498941850e-04f, 6.493816618e-04f, 5.623413017e-04f, 4.869675031e-04f, 4.216965463e-04f, 3.651741135e-04f, 3.162277862e-04f, 2.738419571e-04f, 2.371373848e-04f, 2.053525241e-04f, 1.778279402e-04f, 1.539926452e-04f, 1.333521504e-04f, 1.154782076e-04f};

__device__ __forceinline__ void sincos_acc(float af, float& sn, float& cs) {
    const double a = (double)af;
    const double k = __builtin_rint(a * 0.63661977236758134308);
    const double r = __builtin_fma(-k, 6.123233995736766036e-17, __builtin_fma(-k, 1.57079632679489655800, a));
    const double r2 = r * r;
    double s = -2.5052108385441718775e-8; s = s * r2 + 2.7557319223985890653e-6; s = s * r2 - 1.9841269841269841270e-4; s = s * r2 + 8.3333333333333333333e-3; s = s * r2 - 1.6666666666666666667e-1; s = s * r2 * r + r;
    double c = 2.0876756987868098979e-9; c = c * r2 - 2.7557319223985890653e-7; c = c * r2 + 2.4801587301587301587e-5; c = c * r2 - 1.3888888888888888889e-3; c = c * r2 + 4.1666666666666666667e-2; c = c * r2 - 0.5; c = c * r2 + 1.0;
    const int q = ((int)k) & 3;
    const double ss = (q == 0) ? s : (q == 1) ? c : (q == 2) ? -s : -c;
    const double cc = (q == 0) ? c : (q == 1) ? -s : (q == 2) ? -c : s;
    sn = (float)ss; cs = (float)cc;
}

__host__ __device__ __forceinline__ int tile_kind(int t) {
    if (t < 8) return 0; if (t < 16) return 1; if (t < 20) return 0; if (t == 20 || t == 21) return 1; if (t == 22) return 0; if (t == 23) return 1; if (t == 24) return 0; if (t == 25) return 1; if (t < 30) return 1; return 2;
}
__host__ __device__ __forceinline__ int tile_src_base(int t) { return t < 26 ? t * 256 : (t < 30 ? C_NZ + (t - 26) * 256 : C_NG); }
__host__ __device__ __forceinline__ int win_src_col(int np) {
    const int t = np >> 8, p = np & 255, kind = tile_kind(t), base = tile_src_base(t);
    if (kind == 1) return base + p;
    if (kind == 2) return p < 24 ? base + p : -1;
    const int bj = p >> 7, hl = (p >> 6) & 1, dd = p & 63;
    return base + hl * 128 + bj * 64 + dd;
}

__device__ __forceinline__ void p0_transpose_item(const float* W, int K, int N, bf16* WT, float* scr, int item, int lane, int nblk, int srcmode, const float* gk0, const float* gk1) {
    const int kb = item / nblk, nb = item % nblk, k0 = 64 * kb, n0 = 32 * nb;
    const int np = n0 + (lane & 31);
    const int src = srcmode == 0 ? win_src_col(np) : np;
#pragma unroll 8
    for (int i = 0; i < 32; ++i) { const int kk = 2 * i + (lane >> 5); float v = 0.f;
        if (src >= 0) { v = W[(size_t)(k0 + kk) * N + src]; if (gk0) { const int k = k0 + kk; v *= (k < 1024 ? gk0[k] : gk1[k - 1024]); } }
        scr[kk * 33 + (lane & 31)] = v; }
    asm volatile("s_waitcnt lgkmcnt(0)" ::: "memory");
    const int c = lane & 7;
#pragma unroll
    for (int j = 0; j < 4; ++j) { const int n = (lane >> 3) + 8 * j; const float* s = scr + (8 * c) * 33 + n;
        u32x4 o; o.x = pk2(s[0 * 33], s[1 * 33]); o.y = pk2(s[2 * 33], s[3 * 33]); o.z = pk2(s[4 * 33], s[5 * 33]); o.w = pk2(s[6 * 33], s[7 * 33]);
        *(u32x4*)(WT + (size_t)(n0 + n) * K + k0 + 8 * c) = o; }
    asm volatile("s_waitcnt lgkmcnt(0)" ::: "memory");
}

__device__ __forceinline__ void p0_prologue(const Bufs& Bf, int gw, int NGW, int lane, float* scr) {
    constexpr int I_IN = (2048 / 64) * (NPAD / 32), I_OUT = (2048 / 64) * (2048 / 32), I_C1 = (4096 / 64) * (256 / 32), I_C2 = (256 / 64) * (128 / 32);
    constexpr int NITEMS = I_IN + I_OUT + 2 * I_C1 + 2 * I_C2;
    for (int it = gw; it < NITEMS; it += NGW) {
        int r = it;
        if (r < I_IN) { p0_transpose_item(Bf.w_in, 2048, INC, Bf.b16(WS_WINT), scr, r, lane, NPAD / 32, 0, nullptr, nullptr); continue; } r -= I_IN;
        if (r < I_OUT) { p0_transpose_item(Bf.w_out, 2048, 2048, Bf.b16(WS_WOUTT), scr, r, lane, 2048 / 32, 1, Bf.g_out_moba, Bf.g_out_nsa); continue; } r -= I_OUT;
        if (r < I_C1) { p0_transpose_item(Bf.w_ck1, 4096, 256, Bf.b16(WS_WC1T), scr, r, lane, 256 / 32, 1, nullptr, nullptr); continue; } r -= I_C1;
        if (r < I_C1) { p0_transpose_item(Bf.w_cv1, 4096, 256, Bf.b16(WS_WC1T) + 256 * 4096, scr, r, lane, 256 / 32, 1, nullptr, nullptr); continue; } r -= I_C1;
        if (r < I_C2) { p0_transpose_item(Bf.w_ck2, 256, 128, Bf.b16(WS_WC2T), scr, r, lane, 128 / 32, 1, nullptr, nullptr); continue; } r -= I_C2;
        p0_transpose_item(Bf.w_cv2, 256, 128, Bf.b16(WS_WC2T) + 128 * 256, scr, r, lane, 128 / 32, 1, nullptr, nullptr);
    }
    bf16* H = Bf.b16(WS_H);
    for (int m = gw; m < M; m += NGW) {
        const float* xr = Bf.x + (size_t)m * DM + lane * 8; f32x4 v[8]; float s = 0.f;
#pragma unroll
        for (int j = 0; j < 4; ++j) { v[2 * j] = *(const f32x4*)(xr + j * 512); v[2 * j + 1] = *(const f32x4*)(xr + j * 512 + 4); }
#pragma unroll
        for (int j = 0; j < 8; ++j) s += (v[j].x * v[j].x + v[j].y * v[j].y) + (v[j].z * v[j].z + v[j].w * v[j].w);
        const float rstd = 1.0f / sqrtf(wave_sum(s) * (1.f / DM) + EPS);
#pragma unroll
        for (int j = 0; j < 4; ++j) { const f32x4 g0 = *(const f32x4*)(Bf.g_norm + j * 512 + lane * 8), g1 = *(const f32x4*)(Bf.g_norm + j * 512 + lane * 8 + 4);
            const f32x4 a = v[2 * j] * rstd * g0, b = v[2 * j + 1] * rstd * g1;
            u32x4 o; o.x = pk2(a.x, a.y); o.y = pk2(a.z, a.w); o.z = pk2(b.x, b.y); o.w = pk2(b.z, b.w);
            *(u32x4*)(H + (size_t)m * DM + j * 512 + lane * 8) = o; }
    }
    float* COS = Bf.f32(WS_COS); float* SIN = Bf.f32(WS_SIN);
    for (int i = gw * 64 + lane; i < M * 64; i += NGW * 64) {
        const int row = i >> 6, f = i & 63; const float a = (float)Bf.pos[row] * INV_FREQ[f]; float sn, cs; sincos_acc(a, sn, cs); COS[i] = cs; SIN[i] = sn; }
    float* CB = Bf.f32(WS_CBIAS);
    for (int it = gw; it < 2 * 64; it += NGW) { const int kv = it >> 6, c = it & 63; const float* pe = kv ? Bf.pe_cv : Bf.pe_ck; const float* w1 = kv ? Bf.w_cv1 : Bf.w_ck1;
        float a0 = 0.f, a1 = 0.f, a2 = 0.f, a3 = 0.f;
        for (int k = 64 * c; k < 64 * c + 64; ++k) { const float p = pe[k]; const float* wr = w1 + (size_t)k * 256 + lane; a0 += p * wr[0]; a1 += p * wr[64]; a2 += p * wr[128]; a3 += p * wr[192]; }
        float* o = CB + (size_t)(kv * 64 + c) * 256 + lane; o[0] = a0; o[64] = a1; o[128] = a2; o[192] = a3; }
}

__global__ void __launch_bounds__(256) naive_inproj(Bufs Bf) {
    __shared__ float hs[16][64];
    const int tid = threadIdx.x, dd = tid & 63, u = blockIdx.x * 4 + (tid >> 6), row0 = blockIdx.y * 16;
    const bool uv = u < 61;
    const int cb = !uv ? 0 : (u < 52 ? 128 * u : (u < 60 ? C_NZ + 128 * (u - 52) : C_NG));
    const bool v1ok = uv && (u < 60 || dd < 24), v2ok = uv && u < 60;
    const int c1 = cb + dd, c2 = cb + dd + 64;
    float a1[16], a2[16];
#pragma unroll
    for (int r = 0; r < 16; ++r) { a1[r] = 0.f; a2[r] = 0.f; }
    const bf16* H = Bf.b16(WS_H);
    for (int k0 = 0; k0 < 2048; k0 += 64) {
        __syncthreads();
        for (int i = tid; i < 16 * 64; i += 256) hs[i >> 6][i & 63] = bf2f(H[(size_t)(row0 + (i >> 6)) * 2048 + k0 + (i & 63)]);
        __syncthreads();
        for (int k = 0; k < 64; ++k) {
            const float w1 = v1ok ? Bf.w_in[(size_t)(k0 + k) * INC + c1] : 0.f, w2 = v2ok ? Bf.w_in[(size_t)(k0 + k) * INC + c2] : 0.f;
#pragma unroll
            for (int r = 0; r < 16; ++r) { const float h = hs[r][k]; a1[r] += h * w1; a2[r] += h * w2; }
        }
    }
    if (!uv) return;
    const float* COS = Bf.f32(WS_COS); const float* SIN = Bf.f32(WS_SIN);
    for (int r = 0; r < 16; ++r) {
        const int row = row0 + r, b = row >> 11, s = row & 2047; float v1 = a1[r], v2 = a2[r];
        bf16* dst = nullptr; int nh = 8, head = 0; bool rope = false; bf16* dst_raw = nullptr;
        if (u < 8) { dst = Bf.b16(WS_QM); head = u; rope = true; }
        else if (u < 16) { dst = Bf.b16(WS_KM); head = u - 8; rope = true; }
        else if (u < 24) { dst = Bf.b16(WS_VM); head = u - 16; }
        else if (u < 32) { bf16* gz = Bf.b16(WS_GZ) + (size_t)row * 2048 + (u - 24) * 128; gz[dd] = (bf16)f2bf(silu_f(v1)); gz[dd + 64] = (bf16)f2bf(silu_f(v2)); continue; }
        else if (u < 40) { dst = Bf.b16(WS_NQROT); dst_raw = Bf.b16(WS_NQRAW); head = u - 32; rope = true; }
        else if (u < 42) { dst = Bf.b16(WS_KCIN); head = u - 40; nh = 2; }
        else if (u < 44) { dst = Bf.b16(WS_VCIN); head = u - 42; nh = 2; }
        else if (u < 46) { dst = Bf.b16(WS_KS); head = u - 44; nh = 2; rope = true; }
        else if (u < 48) { dst = Bf.b16(WS_VS); head = u - 46; nh = 2; }
        else if (u < 50) { dst = Bf.b16(WS_KW); head = u - 48; nh = 2; rope = true; }
        else if (u < 52) { dst = Bf.b16(WS_VW); head = u - 50; nh = 2; }
        else if (u < 60) { bf16* gz = Bf.b16(WS_GZ) + (size_t)row * 2048 + 1024 + (u - 52) * 128; gz[dd] = (bf16)f2bf(silu_f(v1)); gz[dd + 64] = (bf16)f2bf(silu_f(v2)); continue; }
        else { if (dd < 24) Bf.f32(WS_GATES)[(size_t)row * 24 + dd] = sigmoid_f(v1); continue; }
        const size_t o = ((size_t)(b * nh + head) * SEQ + s) * HD + dd;
        if (dst_raw) { dst_raw[o] = (bf16)f2bf(v1); dst_raw[o + 64] = (bf16)f2bf(v2); }
        if (rope) { const float c = COS[(size_t)row * 64 + dd], sn = SIN[(size_t)row * 64 + dd]; const float o1 = v1 * c - v2 * sn, o2 = v2 * c + v1 * sn; v1 = o1; v2 = o2; }
        dst[o] = (bf16)f2bf(v1); dst[o + 64] = (bf16)f2bf(v2);
    }
}
__global__ void __launch_bounds__(256) naive_kmean(Bufs Bf) {
    const int i = blockIdx.x * 256 + threadIdx.x; if (i >= 8 * 8 * 8 * 128) return;
    const int d = i & 127, blk = (i >> 7) & 7, bh = i >> 10;
    const bf16* K = Bf.b16(WS_KM) + ((size_t)bh * SEQ + blk * 256) * HD + d; float s = 0.f;
    for (int r = 0; r < 256; ++r) s += bf2f(K[(size_t)r * HD]);
    Bf.f32(WS_KMS)[i] = s;
}
__global__ void __launch_bounds__(256) naive_compress(Bufs Bf) {
    __shared__ float in[4096]; __shared__ float hid[256];
    const int i = blockIdx.x, bg = blockIdx.y, kv = blockIdx.z, tid = threadIdx.x;
    bf16* outp = Bf.b16(kv ? WS_VC : WS_KC) + ((size_t)bg * 128 + i) * 128;
    if (i == 127) { if (tid < 128) outp[tid] = 0; return; }
    const bf16* src = Bf.b16(kv ? WS_VCIN : WS_KCIN) + ((size_t)bg * SEQ + 16 * i) * HD;
    const float* pe = kv ? Bf.pe_cv : Bf.pe_ck; const float* w1 = kv ? Bf.w_cv1 : Bf.w_ck1; const float* w2 = kv ? Bf.w_cv2 : Bf.w_ck2;
    for (int k = tid; k < 4096; k += 256) in[k] = bf2f(src[k]) + pe[k];
    __syncthreads();
    float a = 0.f;
    for (int k = 0; k < 4096; ++k) a += in[k] * w1[(size_t)k * 256 + tid];
    hid[tid] = silu_f(a);
    __syncthreads();
    if (tid < 128) { float o = 0.f; for (int n = 0; n < 256; ++n) o += hid[n] * w2[n * 128 + tid]; outp[tid] = (bf16)f2bf(o); }
}

#define WAVE_LDS_SYNC() asm volatile("s_waitcnt lgkmcnt(0)" ::: "memory")
__device__ __forceinline__ void na_load_q(const bf16* q, float* qf, int lane) { qf[lane] = bf2f(q[lane]); qf[lane + 64] = bf2f(q[lane + 64]); WAVE_LDS_SYNC(); }
__device__ __forceinline__ void na_scores(const float* qf, const bf16* K, int kb, bool valid, int lane, float* sc, int* kidx, int& n) {
    float s = -__builtin_inff();
    if (valid) { const bf16* kr = K + (size_t)(kb + lane) * HD; float a = 0.f;
        for (int d = 0; d < 128; d += 8) { const u32x4 w = *(const u32x4*)(kr + d);
            a += qf[d] * bf2f(w.x & 0xffffu) + qf[d + 1] * bf2f(w.x >> 16) + qf[d + 2] * bf2f(w.y & 0xffffu) + qf[d + 3] * bf2f(w.y >> 16)
               + qf[d + 4] * bf2f(w.z & 0xffffu) + qf[d + 5] * bf2f(w.z >> 16) + qf[d + 6] * bf2f(w.w & 0xffffu) + qf[d + 7] * bf2f(w.w >> 16); }
        s = a * SCALE; }
    sc[n + lane] = s; kidx[n + lane] = kb + lane; n += 64;
}
__device__ __forceinline__ float na_finish(float* sc, const int* kidx, int n, const bf16* V, int lane, float& o0, float& o1) {
    WAVE_LDS_SYNC();
    float m = -__builtin_inff();
    for (int i = lane; i < n; i += 64) m = fmaxf(m, sc[i]);
    m = wave_max(m);
    if (m == -__builtin_inff()) { o0 = 0.f; o1 = 0.f; return 0.f; }
    float l = 0.f;
    for (int i = lane; i < n; i += 64) { const float p = __expf(sc[i] - m); sc[i] = p; l += p; }
    l = wave_sum(l);
    WAVE_LDS_SYNC();
    float a0 = 0.f, a1 = 0.f;
    for (int i = 0; i < n; ++i) { const float p = sc[i]; if (p != 0.f) { const bf16* vr = V + (size_t)kidx[i] * HD; a0 += p * bf2f(vr[lane]); a1 += p * bf2f(vr[lane + 64]); } }
    const float rl = 1.f / l; o0 = a0 * rl; o1 = a1 * rl; return l;
}
__global__ void __launch_bounds__(256) naive_moba(Bufs Bf) {
    __shared__ float sc_[4][1024]; __shared__ int kx_[4][1024]; __shared__ float qf_[4][128];
    const int w = threadIdx.x >> 6, lane = threadIdx.x & 63;
    const int q = blockIdx.x * 4 + w, bh = blockIdx.y, b = bh >> 3, h = bh & 7;
    float* sc = sc_[w]; int* kidx = kx_[w]; float* qf = qf_[w];
    const bf16* Q = Bf.b16(WS_QM) + ((size_t)bh * SEQ + q) * HD; const bf16* K = Bf.b16(WS_KM) + (size_t)bh * SEQ * HD; const bf16* V = Bf.b16(WS_VM) + (size_t)bh * SEQ * HD;
    na_load_q(Q, qf, lane);
    const int own = q >> 8;
    float g = -__builtin_inff();
    if (lane < own) { const float* km = Bf.f32(WS_KMS) + ((size_t)bh * 8 + lane) * 128; float a = 0.f; for (int d = 0; d < 128; ++d) a += qf[d] * km[d]; g = a; }
    int rank = 0;
    for (int k = 0; k < 8; ++k) { const float gk = __shfl(g, k); rank += (gk > g || (gk == g && k < lane)) ? 1 : 0; }
    const bool sel = (lane < own) && rank < 3;
    const unsigned long long selm = __ballot(sel);
    int n = 0;
    for (int j = 0; j < own; ++j) if ((selm >> j) & 1ull) for (int c = 0; c < 4; ++c) na_scores(qf, K, j * 256 + c * 64, true, lane, sc, kidx, n);
    for (int c = 0; c < 4; ++c) { const int kb = own * 256 + c * 64; if (kb <= q) na_scores(qf, K, kb, kb + lane <= q, lane, sc, kidx, n); }
    float o0, o1; na_finish(sc, kidx, n, V, lane, o0, o1);
    const int row = b * SEQ + q; const bf16* gz = Bf.b16(WS_GZ) + (size_t)row * 2048 + h * 128; bf16* T = Bf.b16(WS_T) + (size_t)row * 2048 + h * 128;
    T[lane] = (bf16)f2bf(o0 * bf2f(gz[lane])); T[lane + 64] = (bf16)f2bf(o1 * bf2f(gz[lane + 64]));
}
__global__ void __launch_bounds__(128) naive_nsa(Bufs Bf) {
    __shared__ float sc_[2][640]; __shared__ int kx_[2][640]; __shared__ float qf_[2][128];
    const int w = threadIdx.x >> 6, lane = threadIdx.x & 63;
    const int q = blockIdx.x * 2 + w, bg = blockIdx.y, b = bg >> 1, g = bg & 1;
    float* sc = sc_[w]; int* kidx = kx_[w]; float* qf = qf_[w];
    const int row = b * SEQ + q, own = q >> 6;
    const bf16* KC = Bf.b16(WS_KC) + (size_t)bg * 128 * HD; const bf16* VC = Bf.b16(WS_VC) + (size_t)bg * 128 * HD;
    const bf16* KS = Bf.b16(WS_KS) + (size_t)bg * SEQ * HD; const bf16* VS = Bf.b16(WS_VS) + (size_t)bg * SEQ * HD;
    const bf16* KW = Bf.b16(WS_KW) + (size_t)bg * SEQ * HD; const bf16* VW = Bf.b16(WS_VW) + (size_t)bg * SEQ * HD;
    float oc0[4], oc1[4]; float imp = 0.f;
    for (int r = 0; r < 4; ++r) {
        const int head = g * 4 + r;
        na_load_q(Bf.b16(WS_NQRAW) + ((size_t)(b * 8 + head) * SEQ + q) * HD, qf, lane);
        int n = 0;
        for (int c = 0; c < 2; ++c) { const int key = c * 64 + lane; na_scores(qf, KC, c * 64, key < 127 && 16 * key + 31 <= q, lane, sc, kidx, n); }
        const float l = na_finish(sc, kidx, n, VC, lane, oc0[r], oc1[r]);
        if (l > 0.f && lane < 32) { const float rl = 1.f / l; float a = 0.f;
            for (int t = 4 * lane - 1; t <= 4 * lane + 3; ++t) if (t >= 0 && t < 127) a += sc[t] * rl;
            imp += a; }
        WAVE_LDS_SYNC();
    }
    float s = -__builtin_inff();
    if (lane < 32) { if (lane > own) s = -__builtin_inff(); else if (lane == 0 || lane == own || lane == own - 1) s = __builtin_inff(); else s = imp; }
    int rank = 0;
    for (int k = 0; k < 32; ++k) { const float sk = __shfl(s, k); rank += (sk > s || (sk == s && k < lane)) ? 1 : 0; }
    const bool sel = lane < 32 && rank < 8 && s > -__builtin_inff();
    const unsigned long long selm = __ballot(sel);
    const float* gt = Bf.f32(WS_GATES) + (size_t)row * 24 + g * 12;
    for (int r = 0; r < 4; ++r) {
        const int head = g * 4 + r;
        na_load_q(Bf.b16(WS_NQROT) + ((size_t)(b * 8 + head) * SEQ + q) * HD, qf, lane);
        int n = 0;
        for (int j = 0; j < 32; ++j) if ((selm >> j) & 1ull) na_scores(qf, KS, j * 64, j * 64 + lane <= q, lane, sc, kidx, n);
        float os0, os1; na_finish(sc, kidx, n, VS, lane, os0, os1);
        WAVE_LDS_SYNC();
        n = 0;
        const int lo = q - 511 > 0 ? q - 511 : 0;
        for (int kb = (lo >> 6) << 6; kb <= q; kb += 64) { const int key = kb + lane; na_scores(qf, KW, kb, key <= q && key > q - 512, lane, sc, kidx, n); }
        float ow0, ow1; na_finish(sc, kidx, n, VW, lane, ow0, ow1);
        WAVE_LDS_SYNC();
        const float g0 = gt[r * 3 + 0], g1 = gt[r * 3 + 1], g2 = gt[r * 3 + 2];
        const float v0 = g0 * oc0[r] + g1 * os0 + g2 * ow0, v1 = g0 * oc1[r] + g1 * os1 + g2 * ow1;
        const bf16* gz = Bf.b16(WS_GZ) + (size_t)row * 2048 + 1024 + head * 128; bf16* T = Bf.b16(WS_T) + (size_t)row * 2048 + 1024 + head * 128;
        T[lane] = (bf16)f2bf(v0 * bf2f(gz[lane])); T[lane + 64] = (bf16)f2bf(v1 * bf2f(gz[lane + 64]));
    }
}
__global__ void __launch_bounds__(256) naive_tnorm(Bufs Bf) {
    const int lane = threadIdx.x & 63, row = blockIdx.x * 4 + (threadIdx.x >> 6);
    bf16* T = Bf.b16(WS_T) + (size_t)row * 2048;
    for (int half = 0; half < 2; ++half) {
        bf16* p = T + half * 1024 + lane * 16; u32x4 a = *(u32x4*)p, c = *(u32x4*)(p + 8); unsigned w[8] = {a.x, a.y, a.z, a.w, c.x, c.y, c.z, c.w};
        float s = 0.f;
#pragma unroll
        for (int i = 0; i < 8; ++i) { const float lo = bf2f(w[i] & 0xffffu), hi = bf2f(w[i] >> 16); s += lo * lo + hi * hi; }
        const float rstd = 1.0f / sqrtf(wave_sum(s) * (1.f / 1024.f) + EPS);
#pragma unroll
        for (int i = 0; i < 8; ++i) w[i] = pk2(bf2f(w[i] & 0xffffu) * rstd, bf2f(w[i] >> 16) * rstd);
        *(u32x4*)p = (u32x4){w[0], w[1], w[2], w[3]}; *(u32x4*)(p + 8) = (u32x4){w[4], w[5], w[6], w[7]};
    }
}
__global__ void __launch_bounds__(256) naive_outproj(Bufs Bf) {
    __shared__ float ys[16][64];
    const int tid = threadIdx.x, col = blockIdx.x * 256 + tid, row0 = blockIdx.y * 16;
    float a[16];
#pragma unroll
    for (int r = 0; r < 16; ++r) a[r] = 0.f;
    const bf16* T = Bf.b16(WS_T);
    for (int k0 = 0; k0 < 2048; k0 += 64) {
        __syncthreads();
        for (int i = tid; i < 16 * 64; i += 256) ys[i >> 6][i & 63] = bf2f(T[(size_t)(row0 + (i >> 6)) * 2048 + k0 + (i & 63)]);
        __syncthreads();
        for (int k = 0; k < 64; ++k) { const int e = k0 + k; const float w = Bf.w_out[(size_t)e * 2048 + col] * (e < 1024 ? Bf.g_out_moba[e] : Bf.g_out_nsa[e - 1024]);
#pragma unroll
            for (int r = 0; r < 16; ++r) a[r] += ys[r][k] * w; }
    }
    for (int r = 0; r < 16; ++r) { const size_t o = (size_t)(row0 + r) * 2048 + col; Bf.out[o] = Bf.x[o] + a[r]; }
}
__device__ __forceinline__ void final_norm_row(const Bufs& Bf, int m, int lane) {
    float* xr = Bf.out + (size_t)m * DM + lane * 8; f32x4 v[8]; float s = 0.f;
#pragma unroll
    for (int j = 0; j < 4; ++j) { v[2 * j] = *(const f32x4*)(xr + j * 512); v[2 * j + 1] = *(const f32x4*)(xr + j * 512 + 4); }
#pragma unroll
    for (int j = 0; j < 8; ++j) s += (v[j].x * v[j].x + v[j].y * v[j].y) + (v[j].z * v[j].z + v[j].w * v[j].w);
    const float rstd = 1.0f / sqrtf(wave_sum(s) * (1.f / DM) + EPS);
#pragma unroll
    for (int j = 0; j < 4; ++j) { const f32x4 g0 = *(const f32x4*)(Bf.g_final + j * 512 + lane * 8), g1 = *(const f32x4*)(Bf.g_final + j * 512 + lane * 8 + 4);
        *(f32x4*)(xr + j * 512) = v[2 * j] * rstd * g0; *(f32x4*)(xr + j * 512 + 4) = v[2 * j + 1] * rstd * g1; }
}
__global__ void __launch_bounds__(256) naive_final(Bufs Bf) { final_norm_row(Bf, blockIdx.x * 4 + (threadIdx.x >> 6), threadIdx.x & 63); }

constexpr int NWAVES = 8;
constexpr int LDS_BYTES = 147456;
struct Args { Bufs bf; int ph_lo, ph_hi; };
__global__ void __launch_bounds__(NWAVES * 64, 2) mk_fwd(Args args) {
    extern __shared__ __attribute__((aligned(16))) unsigned char lds[];
    const int tid = threadIdx.x, lane = tid & 63, wave = __builtin_amdgcn_readfirstlane(tid >> 6);
    const int G = gridDim.x, gw = blockIdx.x * NWAVES + wave, NGW = G * NWAVES;
    const int lo = args.ph_lo, hi = args.ph_hi;
    if (lo <= 0 && 0 < hi) p0_prologue(args.bf, gw, NGW, lane, (float*)(lds + wave * 16384));
}

extern "C" void kernel_launch(void* const* d_in, const int* in_sizes, int n_in, void* d_out, int out_size, void* d_ws, size_t ws_size, hipStream_t stream) {
    static int grid = 0;
    if (grid == 0) {
        if (n_in != 14 || in_sizes[0] != M * DM || out_size != M * DM || ws_size < WS_END) {
            fprintf(stderr, "kernel_launch: unexpected shapes: n_in %d in0 %d out %d ws %zu (need %zu)\n", n_in, n_in > 0 ? in_sizes[0] : -1, out_size, ws_size, (size_t)WS_END); grid = -1; return; }
        int dev = 0, cus = 0;
        if (hipGetDevice(&dev) != hipSuccess || hipDeviceGetAttribute(&cus, hipDeviceAttributeMultiprocessorCount, dev) != hipSuccess) { grid = -1; return; }
        if (hipFuncSetAttribute((const void*)mk_fwd, hipFuncAttributeMaxDynamicSharedMemorySize, LDS_BYTES) != hipSuccess) { fprintf(stderr, "kernel_launch: hipFuncSetAttribute failed\n"); grid = -1; return; }
        grid = cus;
    }
    if (grid < 0) return;
    (void)hipMemsetAsync((char*)d_ws + WS_CTL, 0, CTL_ZERO_BYTES, stream);
    Args a{};
    a.bf.x = (const float*)d_in[0]; a.bf.pos = (const int*)d_in[1]; a.bf.w_in = (const float*)d_in[2]; a.bf.g_norm = (const float*)d_in[3];
    a.bf.pe_ck = (const float*)d_in[4]; a.bf.pe_cv = (const float*)d_in[5]; a.bf.w_ck1 = (const float*)d_in[6]; a.bf.w_ck2 = (const float*)d_in[7];
    a.bf.w_cv1 = (const float*)d_in[8]; a.bf.w_cv2 = (const float*)d_in[9]; a.bf.g_out_moba = (const float*)d_in[10]; a.bf.g_out_nsa = (const float*)d_in[11];
    a.bf.w_out = (const float*)d_in[12]; a.bf.g_final = (const float*)d_in[13]; a.bf.out = (float*)d_out; a.bf.ws = (unsigned char*)d_ws;
    a.ph_lo = 0; a.ph_hi = 1;
    hipLaunchKernelGGL(mk_fwd, dim3(grid), dim3(NWAVES * 64), LDS_BYTES, stream, a);
    hipLaunchKernelGGL(naive_inproj, dim3(16, M / 16), dim3(256), 0, stream, a.bf);
    hipLaunchKernelGGL(naive_kmean, dim3(8 * 8 * 8 * 128 / 256), dim3(256), 0, stream, a.bf);
    hipLaunchKernelGGL(naive_compress, dim3(128, 16, 2), dim3(256), 0, stream, a.bf);
    hipLaunchKernelGGL(naive_moba, dim3(SEQ / 4, 64), dim3(256), 0, stream, a.bf);
    hipLaunchKernelGGL(naive_nsa, dim3(SEQ / 2, 16), dim3(128), 0, stream, a.bf);
    hipLaunchKernelGGL(naive_tnorm, dim3(M / 4), dim3(256), 0, stream, a.bf);
    hipLaunchKernelGGL(naive_outproj, dim3(8, M / 16), dim3(256), 0, stream, a.bf);
    hipLaunchKernelGGL(naive_final, dim3(M / 4), dim3(256), 0, stream, a.bf);
}
```

```cpp
#include <hip/hip_runtime.h>
#include <cstdio>
#include <cstdint>

constexpr int NB = 8, SEQ = 2048, DM = 2048, M = NB * SEQ;
constexpr int HD = 128;
constexpr int INC = 7704;
constexpr int C_NG = 6656, C_NZ = 6680;
constexpr float EPS = 1e-6f;
constexpr float SCALE = 0.08838834764831845f;
constexpr int NPAD = 7936;

typedef unsigned short bf16;
typedef short bf16x8 __attribute__((ext_vector_type(8)));
typedef float f32x4 __attribute__((ext_vector_type(4)));
typedef float f32x16 __attribute__((ext_vector_type(16)));
typedef unsigned u32x4 __attribute__((ext_vector_type(4)));
typedef unsigned u32x2 __attribute__((ext_vector_type(2)));

__device__ __forceinline__ unsigned f2bf(float f) { unsigned u = __builtin_bit_cast(unsigned, f); return (u + 0x7fffu + ((u >> 16) & 1u)) >> 16; }
__device__ __forceinline__ unsigned pk2(float lo, float hi) { return f2bf(lo) | (f2bf(hi) << 16); }
__device__ __forceinline__ float bf2f(unsigned b) { return __builtin_bit_cast(float, b << 16); }
__device__ __forceinline__ float silu_f(float v) { return v / (1.f + __expf(-v)); }
__device__ __forceinline__ float sigmoid_f(float v) { return 1.f / (1.f + __expf(-v)); }
__device__ __forceinline__ float wave_sum(float v) {
#pragma unroll
    for (int o = 1; o < 64; o <<= 1) v += __shfl_xor(v, o);
    return v;
}
__device__ __forceinline__ float wave_max(float v) {
#pragma unroll
    for (int o = 1; o < 64; o <<= 1) v = fmaxf(v, __shfl_xor(v, o));
    return v;
}

constexpr size_t MiB = 1u << 20;
constexpr size_t WS_CTL = 0, CTL_ZERO_BYTES = 1 * MiB;
constexpr size_t WS_KMS = 512 * 1024;
constexpr size_t WS_WINT = 2 * MiB;
constexpr size_t WS_WOUTT = 34 * MiB;
constexpr size_t WS_WC1T = 42 * MiB;
constexpr size_t WS_WC2T = 46 * MiB;
constexpr size_t WS_CBIAS = 46 * MiB + 256 * 1024;
constexpr size_t WS_KC = 46 * MiB + 512 * 1024;
constexpr size_t WS_VC = 47 * MiB;
constexpr size_t WS_GATES = 48 * MiB;
constexpr size_t WS_COS = 54 * MiB, WS_SIN = 58 * MiB;
constexpr size_t WS_H = 64 * MiB;
constexpr size_t WS_T = WS_H;
constexpr size_t WS_QM = 128 * MiB, WS_KM = 160 * MiB, WS_VM = 192 * MiB;
constexpr size_t WS_GZ = 224 * MiB;
constexpr size_t WS_NQROT = 288 * MiB, WS_NQRAW = 320 * MiB;
constexpr size_t WS_KCIN = 352 * MiB, WS_VCIN = 360 * MiB, WS_KS = 368 * MiB, WS_VS = 376 * MiB, WS_KW = 384 * MiB, WS_VW = 392 * MiB;
constexpr size_t WS_ACC = 400 * MiB;
constexpr size_t WS_END = 464 * MiB;

struct Bufs {
    const float* x; const int* pos; const float *w_in, *g_norm, *pe_ck, *pe_cv, *w_ck1, *w_ck2, *w_cv1, *w_cv2, *g_out_moba, *g_out_nsa, *w_out, *g_final;
    float* out; unsigned char* ws;
    __device__ __forceinline__ bf16* b16(size_t off) const { return (bf16*)(ws + off); }
    __device__ __forceinline__ float* f32(size_t off) const { return (float*)(ws + off); }
};

__device__ const float INV_FREQ[64] = {
    1.000000000e+00f, 8.659643531e-01f, 7.498942018e-01f, 6.493816376e-01f, 5.623413324e-01f, 4.869675338e-01f, 4.216965139e-01f, 3.651741147e-01f, 3.162277639e-01f, 2.738419771e-01f, 2.371373922e-01f, 2.053525001e-01f, 1.778279394e-01f, 1.539926529e-01f, 1.333521456e-01f, 1.154782027e-01f,
    1.000000015e-01f, 8.659642935e-02f, 7.498941571e-02f, 6.493816525e-02f, 5.623412877e-02f, 4.869675264e-02f, 4.216964915e-02f, 3.651741147e-02f, 3.162277862e-02f, 2.738419734e-02f, 2.371373586e-02f, 2.053524926e-02f, 1.778279431e-02f, 1.539926510e-02f, 1.333521493e-02f, 1.154781971e-02f,
    9.999999776e-03f, 8.659643121e-03f, 7.498942316e-03f, 6.493816618e-03f, 5.623413250e-03f, 4.869675264e-03f, 4.216964822e-03f, 3.651741426e-03f, 3.162277862e-03f, 2.738419687e-03f, 2.371373819e-03f, 2.053525066e-03f, 1.778279431e-03f, 1.539926627e-03f, 1.333521446e-03f, 1.154781901e-03f,
    1.000000047e-03f, 8.659643354e-04f, 7.498941850e-04f, 6.493816618e-04f, 5.623413017e-04f, 4.869675031e-04f, 4.216965463e-04f, 3.651741135e-04f, 3.162277862e-04f, 2.738419571e-04f, 2.371373848e-04f, 2.053525241e-04f, 1.778279402e-04f, 1.539926452e-04f, 1.333521504e-04f, 1.154782076e-04f};

__device__ __forceinline__ void sincos_acc(float af, float& sn, float& cs) {
    const double a = (double)af;
    const double k = __builtin_rint(a * 0.63661977236758134308);
    const double r = __builtin_fma(-k, 6.123233995736766036e-17, __builtin_fma(-k, 1.57079632679489655800, a));
    const double r2 = r * r;
    double s = -2.5052108385441718775e-8; s = s * r2 + 2.7557319223985890653e-6; s = s * r2 - 1.9841269841269841270e-4; s = s * r2 + 8.3333333333333333333e-3; s = s * r2 - 1.6666666666666666667e-1; s = s * r2 * r + r;
    double c = 2.0876756987868098979e-9; c = c * r2 - 2.7557319223985890653e-7; c = c * r2 + 2.4801587301587301587e-5; c = c * r2 - 1.3888888888888888889e-3; c = c * r2 + 4.1666666666666666667e-2; c = c * r2 - 0.5; c = c * r2 + 1.0;
    const int q = ((int)k) & 3;
    const double ss = (q == 0) ? s : (q == 1) ? c : (q == 2) ? -s : -c;
    const double cc = (q == 0) ? c : (q == 1) ? -s : (q == 2) ? -c : s;
    sn = (float)ss; cs = (float)cc;
}

__host__ __device__ __forceinline__ int tile_kind(int t) {
    if (t < 8) return 0; if (t < 16) return 1; if (t < 20) return 0; if (t == 20 || t == 21) return 1; if (t == 22) return 0; if (t == 23) return 1; if (t == 24) return 0; if (t == 25) return 1; if (t < 30) return 1; return 2;
}
__host__ __device__ __forceinline__ int tile_src_base(int t) { return t < 26 ? t * 256 : (t < 30 ? C_NZ + (t - 26) * 256 : C_NG); }
__host__ __device__ __forceinline__ int win_src_col(int np) {
    const int t = np >> 8, p = np & 255, kind = tile_kind(t), base = tile_src_base(t);
    if (kind == 1) return base + p;
    if (kind == 2) return p < 24 ? base + p : -1;
    const int bj = p >> 7, hl = (p >> 6) & 1, dd = p & 63;
    return base + hl * 128 + bj * 64 + dd;
}

__device__ __forceinline__ void p0_transpose_item(const float* W, int K, int N, bf16* WT, float* scr, int item, int lane, int nblk, int srcmode, const float* gk0, const float* gk1) {
    const int kb = item / nblk, nb = item % nblk, k0 = 64 * kb, n0 = 32 * nb;
    const int np = n0 + (lane & 31);
    const int src = srcmode == 0 ? win_src_col(np) : np;
#pragma unroll 8
    for (int i = 0; i < 32; ++i) { const int kk = 2 * i + (lane >> 5); float v = 0.f;
        if (src >= 0) { v = W[(size_t)(k0 + kk) * N + src]; if (gk0) { const int k = k0 + kk; v *= (k < 1024 ? gk0[k] : gk1[k - 1024]); } }
        scr[kk * 33 + (lane & 31)] = v; }
    asm volatile("s_waitcnt lgkmcnt(0)" ::: "memory");
    const int c = lane & 7;
#pragma unroll
    for (int j = 0; j < 4; ++j) { const int n = (lane >> 3) + 8 * j; const float* s = scr + (8 * c) * 33 + n;
        u32x4 o; o.x = pk2(s[0 * 33], s[1 * 33]); o.y = pk2(s[2 * 33], s[3 * 33]); o.z = pk2(s[4 * 33], s[5 * 33]); o.w = pk2(s[6 * 33], s[7 * 33]);
        *(u32x4*)(WT + (size_t)(n0 + n) * K + k0 + 8 * c) = o; }
    asm volatile("s_waitcnt lgkmcnt(0)" ::: "memory");
}

__device__ __forceinline__ void p0_prologue(const Bufs& Bf, int gw, int NGW, int lane, float* scr) {
    constexpr int I_IN = (2048 / 64) * (NPAD / 32), I_OUT = (2048 / 64) * (2048 / 32), I_C1 = (4096 / 64) * (256 / 32), I_C2 = (256 / 64) * (128 / 32);
    constexpr int NITEMS = I_IN + I_OUT + 2 * I_C1 + 2 * I_C2;
    for (int it = gw; it < NITEMS; it += NGW) {
        int r = it;
        if (r < I_IN) { p0_transpose_item(Bf.w_in, 2048, INC, Bf.b16(WS_WINT), scr, r, lane, NPAD / 32, 0, nullptr, nullptr); continue; } r -= I_IN;
        if (r < I_OUT) { p0_transpose_item(Bf.w_out, 2048, 2048, Bf.b16(WS_WOUTT), scr, r, lane, 2048 / 32, 1, Bf.g_out_moba, Bf.g_out_nsa); continue; } r -= I_OUT;
        if (r < I_C1) { p0_transpose_item(Bf.w_ck1, 4096, 256, Bf.b16(WS_WC1T), scr, r, lane, 256 / 32, 1, nullptr, nullptr); continue; } r -= I_C1;
        if (r < I_C1) { p0_transpose_item(Bf.w_cv1, 4096, 256, Bf.b16(WS_WC1T) + 256 * 4096, scr, r, lane, 256 / 32, 1, nullptr, nullptr); continue; } r -= I_C1;
        if (r < I_C2) { p0_transpose_item(Bf.w_ck2, 256, 128, Bf.b16(WS_WC2T), scr, r, lane, 128 / 32, 1, nullptr, nullptr); continue; } r -= I_C2;
        p0_transpose_item(Bf.w_cv2, 256, 128, Bf.b16(WS_WC2T) + 128 * 256, scr, r, lane, 128 / 32, 1, nullptr, nullptr);
    }
    bf16* H = Bf.b16(WS_H);
    for (int m = gw; m < M; m += NGW) {
        const float* xr = Bf.x + (size_t)m * DM + lane * 8; f32x4 v[8]; float s = 0.f;
#pragma unroll
        for (int j = 0; j < 4; ++j) { v[2 * j] = *(const f32x4*)(xr + j * 512); v[2 * j + 1] = *(const f32x4*)(xr + j * 512 + 4); }
#pragma unroll
        for (int j = 0; j < 8; ++j) s += (v[j].x * v[j].x + v[j].y * v[j].y) + (v[j].z * v[j].z + v[j].w * v[j].w);
        const float rstd = 1.0f / sqrtf(wave_sum(s) * (1.f / DM) + EPS);
#pragma unroll
        for (int j = 0; j < 4; ++j) { const f32x4 g0 = *(const f32x4*)(Bf.g_norm + j * 512 + lane * 8), g1 = *(const f32x4*)(Bf.g_norm + j * 512 + lane * 8 + 4);
            const f32x4 a = v[2 * j] * rstd * g0, b = v[2 * j + 1] * rstd * g1;
            u32x4 o; o.x = pk2(a.x, a.y); o.y = pk2(a.z, a.w); o.z = pk2(b.x, b.y); o.w = pk2(b.z, b.w);
            *(u32x4*)(H + (size_t)m * DM + j * 512 + lane * 8) = o; }
    }
    float* COS = Bf.f32(WS_COS); float* SIN = Bf.f32(WS_SIN);
    for (int i = gw * 64 + lane; i < M * 64; i += NGW * 64) {
        const int row = i >> 6, f = i & 63; const float a = (float)Bf.pos[row] * INV_FREQ[f]; float sn, cs; sincos_acc(a, sn, cs); COS[i] = cs; SIN[i] = sn; }
    float* CB = Bf.f32(WS_CBIAS);
    for (int it = gw; it < 2 * 64; it += NGW) { const int kv = it >> 6, c = it & 63; const float* pe = kv ? Bf.pe_cv : Bf.pe_ck; const float* w1 = kv ? Bf.w_cv1 : Bf.w_ck1;
        float a0 = 0.f, a1 = 0.f, a2 = 0.f, a3 = 0.f;
        for (int k = 64 * c; k < 64 * c + 64; ++k) { const float p = pe[k]; const float* wr = w1 + (size_t)k * 256 + lane; a0 += p * wr[0]; a1 += p * wr[64]; a2 += p * wr[128]; a3 += p * wr[192]; }
        float* o = CB + (size_t)(kv * 64 + c) * 256 + lane; o[0] = a0; o[64] = a1; o[128] = a2; o[192] = a3; }
}


namespace pg8 {
#define PG8_LAS __attribute__((address_space(3)))
typedef unsigned short bf16_t;
typedef short bf16x8 __attribute__((ext_vector_type(8)));
typedef float f32x4 __attribute__((ext_vector_type(4)));
typedef unsigned u32x4 __attribute__((ext_vector_type(4)));
constexpr int BM = 256, BK = 64, HALF = 128, HTB = HALF * BK * 2  , STAGE_BYTES = 8 * HTB, NXCD = 8, WGM = 8;

__host__ __device__ __forceinline__ int lds_byte(int r, int c) { const int st = (r >> 4) * 2 + (c >> 5), rr = r & 15, cc = c & 31, ob = rr * 64 + cc * 2; return st * 1024 + (ob ^ (((ob >> 9) & 1) << 5)); }
__host__ __device__ __forceinline__ void stage_rc(int b, int& R, int& C) { const int st = b / 1024, sb = b % 1024, swz = sb ^ (((sb >> 9) & 1) << 5); R = (st >> 1) * 16 + swz / 64; C = (st & 1) * 32 + (swz % 64) / 2; }
__host__ __device__ __forceinline__ int perm32(int rho) { const int n = rho >> 4, i = rho & 15; return 8 * (i >> 2) + 4 * n + (i & 3); }

struct Unit { int pm, pn; };
struct Gemm { const bf16_t* A; const bf16_t* Bt; int M, N, K; };

struct StaticOrder {
    int nM, nN, nwg, G, c;
    __host__ __device__ void init(int M, int N, int G_, int c_) { nM = M / BM; nN = N / BM; nwg = nM * nN; G = G_; c = c_; }
    __host__ __device__ bool next(int i, Unit& u) const {
        const long L = (long)i * G + c; if (L >= nwg) return false;
        int wgid = (int)L; { const int q = nwg / NXCD, r = nwg % NXCD, xcd = wgid % NXCD, off = wgid / NXCD; wgid = (xcd < r ? xcd * (q + 1) : r * (q + 1) + (xcd - r) * q) + off; }
        const int nig = WGM * nN, gid = wgid / nig, fm = gid * WGM, gsz = (nM - fm) < WGM ? (nM - fm) : WGM;
        u.pm = fm + ((wgid % nig) % gsz); u.pn = (wgid % nig) / gsz; return true;
    }
    __device__ __forceinline__ void a_ready(const Unit&) const {}
    __device__ __forceinline__ void done(const Unit&) const {}
};

__device__ __forceinline__ unsigned cvt_pk_bf16(float lo, float hi) { unsigned r; asm volatile("v_cvt_pk_bf16_f32 %0, %1, %2" : "=v"(r) : "v"(lo), "v"(hi)); return r; }

template <class Epi, class Sched, bool ALIGN_EPI = false, bool SP2 = false>
__device__ __forceinline__ void gemm_phase(PG8_LAS unsigned char* lds, const Gemm g, const Sched& S, const Epi& E) {
    const int tid = threadIdx.x, wid = __builtin_amdgcn_readfirstlane(tid >> 6), lane = tid & 63, wr = wid >> 2, wc = wid & 3, fr = lane & 15, fq = lane >> 4;
    const int K = g.K, nt = K / BK;
    unsigned voffA[2], voffB[2];
#pragma unroll
    for (int i = 0; i < 2; ++i) { int R, C; stage_rc(tid * 16 + i * 8192, R, C); const int Rb = Epi::PERM ? ((R & ~31) + perm32(R & 31)) : R;
        voffA[i] = (unsigned)(R * K + C) * 2u; voffB[i] = (unsigned)(Rb * K + C) * 2u; }
    const size_t kstep = (size_t)(BK * 2);
    const size_t hstep = (size_t)HALF * K * 2;
    const size_t tstep = 2 * hstep;
    const unsigned ldsw = (unsigned)wid * 1024u;
    const int aoff = lds_byte(wr * 64 + fr, fq * 8), boff = lds_byte(wc * 32 + fr, fq * 8);
#define PG8_SA(b, h) (((b) * 2 + (h)) * HTB)
#define PG8_SB(b, h) ((4 + (b) * 2 + (h)) * HTB)
#define PG8_STAGE(bufoff, gbase, voff) do { _Pragma("unroll") for (int _i = 0; _i < 2; ++_i) \
        __builtin_amdgcn_global_load_lds((const unsigned*)((const char*)(gbase) + (voff)[_i]), (PG8_LAS unsigned*)(lds + (bufoff) + ldsw + _i * 8192), 16, 0, 0); } while (0)
#define PG8_LDA(dst, b, h) do { _Pragma("unroll") for (int m = 0; m < 4; ++m) _Pragma("unroll") for (int k = 0; k < 2; ++k) dst[m][k] = *(const PG8_LAS bf16x8*)(lds + PG8_SA(b, h) + aoff + m * 2048 + k * 1024); } while (0)
#define PG8_LDB(dst, b, h) do { _Pragma("unroll") for (int n = 0; n < 2; ++n) _Pragma("unroll") for (int k = 0; k < 2; ++k) dst[n][k] = *(const PG8_LAS bf16x8*)(lds + PG8_SB(b, h) + boff + n * 2048 + k * 1024); } while (0)
#define PG8_MMA(ai, bj, At, Bt) do { __builtin_amdgcn_s_setprio(1); _Pragma("unroll") for (int m = 0; m < 4; ++m) _Pragma("unroll") for (int n = 0; n < 2; ++n) _Pragma("unroll") for (int k = 0; k < 2; ++k) \
        acc[ai][bj][m][n] = __builtin_amdgcn_mfma_f32_16x16x32_bf16(Bt[n][k], At[m][k], acc[ai][bj][m][n], 0, 0, 0); __builtin_amdgcn_s_setprio(0); } while (0)
#define PG8_WAIT_V(n) asm volatile("s_waitcnt vmcnt(" #n ")" ::: "memory")
#define PG8_WAIT_L(n) asm volatile("s_waitcnt lgkmcnt(" #n ")" ::: "memory")
#define PG8_BAR __builtin_amdgcn_s_barrier()
#define PG8_SCHED __builtin_amdgcn_sched_barrier(0)
    Unit cur, nxt; int ui = 0;
    if (!S.next(0, cur)) return;
    f32x4 acc[2][2][4][2];
#pragma unroll
    for (int a = 0; a < 2; ++a)
#pragma unroll
        for (int b = 0; b < 2; ++b)
#pragma unroll
            for (int m = 0; m < 4; ++m)
#pragma unroll
                for (int n = 0; n < 2; ++n) acc[a][b][m][n] = (f32x4){0.f, 0.f, 0.f, 0.f};
    bf16x8 At[4][2], B0[2][2], B1[2][2];
    const char* cA = (const char*)g.A + (size_t)cur.pm * tstep; const char* cB = (const char*)g.Bt + (size_t)cur.pn * tstep;
    S.a_ready(cur);
    if constexpr (SP2) {
        PG8_STAGE(PG8_SB(0, 0), cB, voffB); PG8_STAGE(PG8_SB(0, 1), cB + hstep, voffB); PG8_STAGE(PG8_SA(0, 0), cA, voffA); PG8_STAGE(PG8_SA(0, 1), cA + hstep, voffA);
        if (wr == 1) PG8_BAR;
        PG8_WAIT_V(2); PG8_BAR;
        PG8_STAGE(PG8_SB(1, 0), cB + kstep, voffB); PG8_STAGE(PG8_SA(1, 0), cA + kstep, voffA); PG8_STAGE(PG8_SB(1, 1), cB + hstep + kstep, voffB);
        PG8_WAIT_V(6); PG8_BAR;
    } else {
        PG8_STAGE(PG8_SB(0, 0), cB, voffB); PG8_STAGE(PG8_SA(0, 0), cA, voffA); PG8_STAGE(PG8_SB(0, 1), cB + hstep, voffB); PG8_STAGE(PG8_SA(0, 1), cA + hstep, voffA);
        if (wr == 1) PG8_BAR;
        PG8_WAIT_V(4); PG8_BAR;
        PG8_STAGE(PG8_SB(1, 0), cB + kstep, voffB); PG8_STAGE(PG8_SA(1, 0), cA + kstep, voffA); PG8_STAGE(PG8_SB(1, 1), cB + hstep + kstep, voffB);
        PG8_WAIT_V(6); PG8_BAR;
    }
    for (;;) {
        const bool has_next = S.next(ui + 1, nxt);
        const char* nA = has_next ? (const char*)g.A + (size_t)nxt.pm * tstep : cA; const char* nB = has_next ? (const char*)g.Bt + (size_t)nxt.pn * tstep : cB;
        for (int t = 0; t < nt; t += 2) {
            const bool last = (t == nt - 2);
            const char* a1 = cA + (size_t)(t + 1) * kstep;
            const char* a2 = last ? nA : cA + (size_t)(t + 2) * kstep; const char* b2 = last ? nB : cB + (size_t)(t + 2) * kstep;
            const char* a3 = a2 + kstep; const char* b3 = b2 + kstep;
            if (last && has_next) S.a_ready(nxt);
            if constexpr (SP2) {
            PG8_LDB(B0, 0, 0); PG8_LDB(B1, 0, 1); PG8_SCHED; PG8_LDA(At, 0, 0); PG8_STAGE(PG8_SA(1, 1), a1 + hstep, voffA);
            PG8_WAIT_V(8); PG8_WAIT_L(0); PG8_BAR; PG8_MMA(0, 0, At, B0); PG8_MMA(0, 1, At, B1); PG8_BAR; PG8_SCHED;
            PG8_LDA(At, 0, 1); PG8_STAGE(PG8_SB(0, 0), b2, voffB); PG8_STAGE(PG8_SB(0, 1), b2 + hstep, voffB); PG8_STAGE(PG8_SA(0, 0), a2, voffA);
            PG8_WAIT_V(8); PG8_WAIT_L(0); PG8_BAR; PG8_MMA(1, 0, At, B0); PG8_MMA(1, 1, At, B1); PG8_BAR; PG8_SCHED;
            PG8_LDB(B0, 1, 0); PG8_LDB(B1, 1, 1); PG8_SCHED; PG8_LDA(At, 1, 0); PG8_STAGE(PG8_SA(0, 1), a2 + hstep, voffA);
            PG8_WAIT_V(8); PG8_WAIT_L(0); PG8_BAR; PG8_MMA(0, 0, At, B0); PG8_MMA(0, 1, At, B1); PG8_BAR; PG8_SCHED;
            PG8_LDA(At, 1, 1); PG8_STAGE(PG8_SB(1, 0), b3, voffB); PG8_STAGE(PG8_SB(1, 1), b3 + hstep, voffB); PG8_STAGE(PG8_SA(1, 0), a3, voffA);
            PG8_WAIT_V(8); PG8_WAIT_L(0); PG8_BAR; PG8_MMA(1, 0, At, B0); PG8_MMA(1, 1, At, B1); PG8_BAR; PG8_SCHED;
            } else {
            PG8_LDB(B0, 0, 0); PG8_SCHED; PG8_LDA(At, 0, 0); PG8_STAGE(PG8_SA(1, 1), a1 + hstep, voffA);
            PG8_WAIT_L(8); PG8_BAR; PG8_WAIT_L(0); PG8_MMA(0, 0, At, B0); PG8_BAR; PG8_SCHED;
            PG8_LDB(B1, 0, 1); PG8_STAGE(PG8_SB(0, 0), b2, voffB);
            PG8_BAR; PG8_WAIT_L(0); PG8_MMA(0, 1, At, B1); PG8_BAR;
            PG8_LDA(At, 0, 1); PG8_STAGE(PG8_SA(0, 0), a2, voffA);
            PG8_BAR; PG8_WAIT_L(0); PG8_MMA(1, 0, At, B0); PG8_BAR; PG8_SCHED;
            PG8_STAGE(PG8_SB(0, 1), b2 + hstep, voffB);
            PG8_WAIT_V(6); PG8_BAR; PG8_MMA(1, 1, At, B1); PG8_BAR;
            PG8_LDB(B0, 1, 0); PG8_SCHED; PG8_LDA(At, 1, 0); PG8_STAGE(PG8_SA(0, 1), a2 + hstep, voffA);
            PG8_WAIT_L(8); PG8_BAR; PG8_WAIT_L(0); PG8_MMA(0, 0, At, B0); PG8_BAR; PG8_SCHED;
            PG8_LDB(B1, 1, 1); PG8_STAGE(PG8_SB(1, 0), b3, voffB);
            PG8_BAR; PG8_WAIT_L(0); PG8_MMA(0, 1, At, B1); PG8_BAR;
            PG8_LDA(At, 1, 1); PG8_STAGE(PG8_SA(1, 0), a3, voffA);
            PG8_BAR; PG8_WAIT_L(0); PG8_MMA(1, 0, At, B0); PG8_BAR; PG8_SCHED;
            PG8_STAGE(PG8_SB(1, 1), b3 + hstep, voffB);
            PG8_WAIT_V(6); PG8_BAR; PG8_MMA(1, 1, At, B1); PG8_BAR;
            }
        }
        if constexpr (ALIGN_EPI) { if (wr == 0) PG8_BAR; }
        if constexpr (!Epi::AFTER_DRAIN) { E(acc, cur, wr, wc, fr, fq); S.done(cur); }
        if (!has_next) break;
#pragma unroll
        for (int a = 0; a < 2; ++a)
#pragma unroll
            for (int b = 0; b < 2; ++b)
#pragma unroll
                for (int m = 0; m < 4; ++m)
#pragma unroll
                    for (int n = 0; n < 2; ++n) acc[a][b][m][n] = (f32x4){0.f, 0.f, 0.f, 0.f};
        cur = nxt; cA = nA; cB = nB; ++ui;
        if constexpr (ALIGN_EPI) { if (wr == 1) PG8_BAR; }
    }
    PG8_WAIT_V(0);
    if constexpr (!ALIGN_EPI) { if (wr == 0) PG8_BAR; }
    PG8_BAR;
    if constexpr (Epi::AFTER_DRAIN) { E.fused(acc, cur, wr, wc, fr, fq, lds, wid, lane); S.done(cur); }
#undef PG8_SA
#undef PG8_SB
#undef PG8_STAGE
#undef PG8_LDA
#undef PG8_LDB
#undef PG8_MMA
#undef PG8_WAIT_V
#undef PG8_WAIT_L
#undef PG8_BAR
#undef PG8_SCHED
}
}

struct EpiIn {
    static constexpr bool PERM = true, AFTER_DRAIN = false;
    Bufs bf;
    __device__ __forceinline__ void operator()(const f32x4 (&acc)[2][2][4][2], const pg8::Unit& u, int wr, int wc, int fr, int fq) const {
        const int t = u.pn, kind = tile_kind(t);
        const int b = u.pm >> 3, s0 = (u.pm & 7) * 256 + wr * 64 + fr, row0 = u.pm * 256 + wr * 64 + fr;
        if (kind == 0) {
            bf16* dst; bf16* raw = nullptr; int nh = 8, hb = 0;
            if (t < 4) { dst = bf.b16(WS_QM); hb = 2 * t; } else if (t < 8) { dst = bf.b16(WS_KM); hb = 2 * (t - 4); }
            else if (t < 20) { dst = bf.b16(WS_NQROT); raw = bf.b16(WS_NQRAW); hb = 2 * (t - 16); } else if (t == 22) { dst = bf.b16(WS_KS); nh = 2; } else { dst = bf.b16(WS_KW); nh = 2; }
            const int head = hb + (wc >> 1), dd0 = 32 * (wc & 1) + 8 * fq;
            const bool km = (t >= 4 && t < 8);
            const float* COS = bf.f32(WS_COS); const float* SIN = bf.f32(WS_SIN);
            f32x4 k1a = {0.f, 0.f, 0.f, 0.f}, k1b = k1a, k2a = k1a, k2b = k1a;
#pragma unroll
            for (int ai = 0; ai < 2; ++ai)
#pragma unroll
                for (int m = 0; m < 4; ++m) {
                    const int s = s0 + 128 * ai + 16 * m, row = row0 + 128 * ai + 16 * m;
                    const f32x4 c0 = *(const f32x4*)(COS + (size_t)row * 64 + dd0), c1 = *(const f32x4*)(COS + (size_t)row * 64 + dd0 + 4);
                    const f32x4 n0 = *(const f32x4*)(SIN + (size_t)row * 64 + dd0), n1 = *(const f32x4*)(SIN + (size_t)row * 64 + dd0 + 4);
                    const f32x4 x1a = acc[ai][0][m][0], x1b = acc[ai][0][m][1], x2a = acc[ai][1][m][0], x2b = acc[ai][1][m][1];
                    const f32x4 o1a = x1a * c0 - x2a * n0, o1b = x1b * c1 - x2b * n1, o2a = x2a * c0 + x1a * n0, o2b = x2b * c1 + x1b * n1;
                    const size_t o = ((size_t)(b * nh + head) * SEQ + s) * HD + dd0;
                    u32x4 w; w.x = pg8::cvt_pk_bf16(o1a[0], o1a[1]); w.y = pg8::cvt_pk_bf16(o1a[2], o1a[3]); w.z = pg8::cvt_pk_bf16(o1b[0], o1b[1]); w.w = pg8::cvt_pk_bf16(o1b[2], o1b[3]);
                    *(u32x4*)(dst + o) = w;
                    w.x = pg8::cvt_pk_bf16(o2a[0], o2a[1]); w.y = pg8::cvt_pk_bf16(o2a[2], o2a[3]); w.z = pg8::cvt_pk_bf16(o2b[0], o2b[1]); w.w = pg8::cvt_pk_bf16(o2b[2], o2b[3]);
                    *(u32x4*)(dst + o + 64) = w;
                    if (raw) {
                        w.x = pg8::cvt_pk_bf16(x1a[0], x1a[1]); w.y = pg8::cvt_pk_bf16(x1a[2], x1a[3]); w.z = pg8::cvt_pk_bf16(x1b[0], x1b[1]); w.w = pg8::cvt_pk_bf16(x1b[2], x1b[3]);
                        *(u32x4*)(raw + o) = w;
                        w.x = pg8::cvt_pk_bf16(x2a[0], x2a[1]); w.y = pg8::cvt_pk_bf16(x2a[2], x2a[3]); w.z = pg8::cvt_pk_bf16(x2b[0], x2b[1]); w.w = pg8::cvt_pk_bf16(x2b[2], x2b[3]);
                        *(u32x4*)(raw + o + 64) = w;
                    }
                    if (km) { k1a += o1a; k1b += o1b; k2a += o2a; k2b += o2b; }
                }
            if (km) {
#pragma unroll
                for (int off = 1; off < 16; off <<= 1)
#pragma unroll
                    for (int j = 0; j < 4; ++j) { k1a[j] += __shfl_xor(k1a[j], off); k1b[j] += __shfl_xor(k1b[j], off); k2a[j] += __shfl_xor(k2a[j], off); k2b[j] += __shfl_xor(k2b[j], off); }
                if (fr == 0) { float* kp = bf.f32(WS_KMS) + ((size_t)(b * 8 + head) * 8 + (u.pm & 7)) * 128 + dd0;
#pragma unroll
                    for (int j = 0; j < 4; ++j) { atomicAdd(kp + j, k1a[j]); atomicAdd(kp + 4 + j, k1b[j]); atomicAdd(kp + 64 + j, k2a[j]); atomicAdd(kp + 68 + j, k2b[j]); } }
            }
        } else if (kind == 1) {
            const bool isz = (t >= 12 && t < 16) || t >= 26;
            if (isz) {
                bf16* gz = bf.b16(WS_GZ) + (t < 16 ? (t - 12) * 256 : 1024 + (t - 26) * 256) + 32 * wc + 8 * fq;
#pragma unroll
                for (int ai = 0; ai < 2; ++ai)
#pragma unroll
                    for (int m = 0; m < 4; ++m) { const int row = row0 + 128 * ai + 16 * m;
#pragma unroll
                        for (int bj = 0; bj < 2; ++bj) { const f32x4 a = acc[ai][bj][m][0], c = acc[ai][bj][m][1];
                            u32x4 w; w.x = pg8::cvt_pk_bf16(silu_f(a[0]), silu_f(a[1])); w.y = pg8::cvt_pk_bf16(silu_f(a[2]), silu_f(a[3])); w.z = pg8::cvt_pk_bf16(silu_f(c[0]), silu_f(c[1])); w.w = pg8::cvt_pk_bf16(silu_f(c[2]), silu_f(c[3]));
                            *(u32x4*)(gz + (size_t)row * 2048 + 128 * bj) = w; } }
            } else {
                bf16* dst; int nh = 2, hb = 0;
                if (t < 12) { dst = bf.b16(WS_VM); nh = 8; hb = 2 * (t - 8); } else if (t == 20) dst = bf.b16(WS_KCIN); else if (t == 21) dst = bf.b16(WS_VCIN); else if (t == 23) dst = bf.b16(WS_VS); else dst = bf.b16(WS_VW);
#pragma unroll
                for (int ai = 0; ai < 2; ++ai)
#pragma unroll
                    for (int m = 0; m < 4; ++m) { const int s = s0 + 128 * ai + 16 * m;
#pragma unroll
                        for (int bj = 0; bj < 2; ++bj) { const f32x4 a = acc[ai][bj][m][0], c = acc[ai][bj][m][1];
                            u32x4 w; w.x = pg8::cvt_pk_bf16(a[0], a[1]); w.y = pg8::cvt_pk_bf16(a[2], a[3]); w.z = pg8::cvt_pk_bf16(c[0], c[1]); w.w = pg8::cvt_pk_bf16(c[2], c[3]);
                            *(u32x4*)(dst + ((size_t)(b * nh + hb + bj) * SEQ + s) * HD + 32 * wc + 8 * fq) = w; } }
            }
        } else {
            if (wc == 0 && fq < 3) { float* gp = bf.f32(WS_GATES) + 8 * fq;
#pragma unroll
                for (int ai = 0; ai < 2; ++ai)
#pragma unroll
                    for (int m = 0; m < 4; ++m) { const int row = row0 + 128 * ai + 16 * m; const f32x4 a = acc[ai][0][m][0], c = acc[ai][0][m][1];
                        *(f32x4*)(gp + (size_t)row * 24) = (f32x4){sigmoid_f(a[0]), sigmoid_f(a[1]), sigmoid_f(a[2]), sigmoid_f(a[3])};
                        *(f32x4*)(gp + (size_t)row * 24 + 4) = (f32x4){sigmoid_f(c[0]), sigmoid_f(c[1]), sigmoid_f(c[2]), sigmoid_f(c[3])}; } }
        }
    }
};
struct EpiOut {
    static constexpr bool PERM = false, AFTER_DRAIN = false;
    const float* x; float* out;
    __device__ __forceinline__ void operator()(const f32x4 (&acc)[2][2][4][2], const pg8::Unit& u, int wr, int wc, int fr, int fq) const {
        const int row0 = u.pm * 256 + wr * 64 + fr, col0 = u.pn * 256 + wc * 32 + 4 * fq;
#pragma unroll
        for (int ai = 0; ai < 2; ++ai)
#pragma unroll
            for (int m = 0; m < 4; ++m) { const size_t off = (size_t)(row0 + 128 * ai + 16 * m) * DM + col0;
#pragma unroll
                for (int bj = 0; bj < 2; ++bj)
#pragma unroll
                    for (int n = 0; n < 2; ++n) { const size_t o = off + bj * 128 + n * 16; *(f32x4*)(out + o) = *(const f32x4*)(x + o) + acc[ai][bj][m][n]; } }
    }
};

namespace att {
constexpr int SHM_K = 16384, SHM_V = 16384;
constexpr int L_V = 0, L_K = 32768, L_WS = 65536, L_SEL = 67584, L_ITEM = 67840, L_IMP = 68096, L_SCORE = L_IMP + 32768, L_ACC = L_IMP;
constexpr float THR = 8.f;
constexpr float C2 = 1.4426950408889634f * SCALE;
constexpr unsigned WBIG = 0x7fffffffu;
#define KSWZ(row, colB) ((row) * 256 + ((colB) ^ (((row) & 7) << 4)))
#define SBAR() __builtin_amdgcn_sched_barrier(0)
__device__ __forceinline__ int v_st(int k, int c) { const int kk = (k & ~0xC) | ((k & 4) << 1) | ((k & 8) >> 1); return ((kk >> 3) * 4 + (c >> 5)) * 512 + ((kk & 7) * 32 + (c & 31)) * 2; }
__device__ __forceinline__ int v_rd_base(int lane) { return ((lane & 3) << 3) | (((lane >> 2) & 3) << 6) | (((lane >> 4) & 1) << 5) | (((lane >> 5) & 1) << 8); }
constexpr int v_rd_off(int d0, int ks, int half) { return d0 * 512 + ks * 4096 + half * 2048; }
__device__ __forceinline__ int crow(int r, int hi) { return (r & 3) + 8 * (r >> 2) + 4 * hi; }
__device__ __forceinline__ unsigned cvtpk(float lo, float hi) { unsigned r; asm volatile("v_cvt_pk_bf16_f32 %0, %1, %2" : "=v"(r) : "v"(lo), "v"(hi)); return r; }
typedef short s16x4 __attribute__((ext_vector_type(4)));
__device__ __forceinline__ int opaque_tid() { int t = threadIdx.x; asm volatile("" : "+v"(t)); return t; }

__device__ __forceinline__ void mask_tile(f32x16& p0, f32x16& p1, int dq, unsigned W) {
    const float NEG = -__builtin_inff();
#pragma unroll
    for (int r = 0; r < 16; ++r) { const int c = (r & 3) + 8 * (r >> 2);
        if ((unsigned)(dq - c) >= W) p0[r] = NEG;
        if ((unsigned)(dq - c - 32) >= W) p1[r] = NEG; }
}
#define PK4(P, B_, OUT) do { unsigned a0 = cvtpk(P[B_+0], P[B_+1]), a1 = cvtpk(P[B_+2], P[B_+3]); unsigned b0 = cvtpk(P[B_+4], P[B_+5]), b1 = cvtpk(P[B_+6], P[B_+7]); \
        auto r0 = __builtin_amdgcn_permlane32_swap(a0, b0, false, false); auto r1 = __builtin_amdgcn_permlane32_swap(a1, b1, false, false); \
        u32x4 w = {r0[0], r1[0], r0[1], r1[1]}; OUT = *reinterpret_cast<bf16x8*>(&w); } while (0)
__device__ __forceinline__ float softmax_tile(f32x16& p0, f32x16& p1, float& m_reg, float& l_reg, bool rowok, bf16x8& pa0, bf16x8& pa1, bf16x8& pa2, bf16x8& pa3) {
    float pmax = p0[0];
#pragma unroll
    for (int r = 1; r < 16; ++r) pmax = fmaxf(pmax, p0[r]);
#pragma unroll
    for (int r = 0; r < 16; ++r) pmax = fmaxf(pmax, p1[r]);
    { auto rr = __builtin_amdgcn_permlane32_swap(__float_as_uint(pmax), __float_as_uint(pmax), false, false); pmax = fmaxf(__uint_as_float(rr[0]), __uint_as_float(rr[1])); }
    if (!rowok) pmax = -__builtin_inff();
    float mn, alpha;
    if (__builtin_expect(__all((pmax - m_reg) * SCALE <= THR), 1)) { mn = m_reg; alpha = 1.f; }
    else { mn = fmaxf(m_reg, pmax); alpha = __builtin_amdgcn_exp2f((m_reg - mn) * C2); m_reg = mn; }
    const float mnL = rowok ? -mn * C2 : -__builtin_inff();
#pragma unroll
    for (int r = 0; r < 16; ++r) { p0[r] = __builtin_amdgcn_exp2f(fmaf(p0[r], C2, mnL)); p1[r] = __builtin_amdgcn_exp2f(fmaf(p1[r], C2, mnL)); }
    float ps = 0.f;
#pragma unroll
    for (int r = 0; r < 16; ++r) ps += p0[r];
#pragma unroll
    for (int r = 0; r < 16; ++r) ps += p1[r];
    { auto rr = __builtin_amdgcn_permlane32_swap(__float_as_uint(ps), __float_as_uint(ps), false, false); ps = __uint_as_float(rr[0]) + __uint_as_float(rr[1]); }
    l_reg = l_reg * alpha + ps;
    PK4(p0, 0, pa0); PK4(p0, 8, pa1); PK4(p1, 0, pa2); PK4(p1, 8, pa3);
    return alpha;
}
__device__ __forceinline__ void qkt(f32x16& p0, f32x16& p1, const char* Kb, int r32, int hi, const bf16x8 (&qr)[8]) {
    p0 = f32x16{}; p1 = f32x16{};
    const char* kb[4];
#pragma unroll
    for (int dd = 0; dd < 4; ++dd) kb[dd] = Kb + KSWZ(r32, (dd * 16 + hi * 8) * 2);
#pragma unroll
    for (int d0 = 0; d0 < 8; ++d0) { const char* a = kb[d0 & 3] + (d0 >> 2) * 128;
        const bf16x8 b0 = *reinterpret_cast<const bf16x8*>(a);
        const bf16x8 b1 = *reinterpret_cast<const bf16x8*>(a + 32 * 256);
        p0 = __builtin_amdgcn_mfma_f32_32x32x16_bf16(b0, qr[d0], p0, 0, 0, 0);
        p1 = __builtin_amdgcn_mfma_f32_32x32x16_bf16(b1, qr[d0], p1, 0, 0, 0); }
}
__device__ __forceinline__ void qkt_half(f32x16& p0, const char* Kb, int r32, int hi, const bf16x8 (&qr)[8]) {
    p0 = f32x16{};
    const char* kb[4];
#pragma unroll
    for (int dd = 0; dd < 4; ++dd) kb[dd] = Kb + KSWZ(r32, (dd * 16 + hi * 8) * 2);
#pragma unroll
    for (int d0 = 0; d0 < 8; ++d0) { const char* a = kb[d0 & 3] + (d0 >> 2) * 128;
        const bf16x8 b0 = *reinterpret_cast<const bf16x8*>(a);
        p0 = __builtin_amdgcn_mfma_f32_32x32x16_bf16(b0, qr[d0], p0, 0, 0, 0); }
}
__device__ __forceinline__ void pv_tile(f32x16 (&o)[4], int vb0, bf16x8 pa0, bf16x8 pa1, bf16x8 pa2, bf16x8 pa3) {
#define TRRD(dst, off) asm volatile("ds_read_b64_tr_b16 %0, %1 offset:%2" : "=&v"(dst) : "v"(vb0), "i"(off) : "memory")
#define PV_D0(d0) do { s16x4 l0, l1, l2, l3, h0, h1, h2, h3; constexpr int b_ = v_rd_off(d0, 0, 0); \
        TRRD(l0, b_); TRRD(h0, b_ + 2048); TRRD(l1, b_ + 4096); TRRD(h1, b_ + 6144); TRRD(l2, b_ + 8192); TRRD(h2, b_ + 10240); TRRD(l3, b_ + 12288); TRRD(h3, b_ + 14336); \
        asm volatile("s_waitcnt lgkmcnt(0)" ::: "memory"); SBAR(); \
        o[d0] = __builtin_amdgcn_mfma_f32_32x32x16_bf16(pa0, (bf16x8){l0[0], l0[1], l0[2], l0[3], h0[0], h0[1], h0[2], h0[3]}, o[d0], 0, 0, 0); \
        o[d0] = __builtin_amdgcn_mfma_f32_32x32x16_bf16(pa1, (bf16x8){l1[0], l1[1], l1[2], l1[3], h1[0], h1[1], h1[2], h1[3]}, o[d0], 0, 0, 0); \
        o[d0] = __builtin_amdgcn_mfma_f32_32x32x16_bf16(pa2, (bf16x8){l2[0], l2[1], l2[2], l2[3], h2[0], h2[1], h2[2], h2[3]}, o[d0], 0, 0, 0); \
        o[d0] = __builtin_amdgcn_mfma_f32_32x32x16_bf16(pa3, (bf16x8){l3[0], l3[1], l3[2], l3[3], h3[0], h3[1], h3[2], h3[3]}, o[d0], 0, 0, 0); } while (0)
    PV_D0(0); PV_D0(1); PV_D0(2); PV_D0(3);
#undef PV_D0
#undef TRRD
}
struct Stage { bf16x8 k0, k1, v0, v1; };
__device__ __forceinline__ void stage_load(Stage& S, const bf16* K, const bf16* V, int krow, int sr, int sc) {
    S.v0 = *(const bf16x8*)(V + (size_t)(krow + sr) * HD + sc); S.v1 = *(const bf16x8*)(V + (size_t)(krow + 32 + sr) * HD + sc);
    S.k0 = *(const bf16x8*)(K + (size_t)(krow + sr) * HD + sc); S.k1 = *(const bf16x8*)(K + (size_t)(krow + 32 + sr) * HD + sc);
}
__device__ __forceinline__ void stage_write(const Stage& S, char* Kb, char* Vb, int kws, int vst0, int vst1) {
    *(bf16x8*)(Kb + kws) = S.k0; *(bf16x8*)(Kb + kws + 32 * 256) = S.k1; *(bf16x8*)(Vb + vst0) = S.v0; *(bf16x8*)(Vb + vst1) = S.v1;
}
#define RESC(a) do { if (__any((a) < 1.f)) { if (hi == 0) al_l[r32] = (a); asm volatile("s_waitcnt lgkmcnt(0)" ::: "memory"); \
        _Pragma("unroll") for (int d_ = 0; d_ < 4; ++d_) _Pragma("unroll") for (int r = 0; r < 16; ++r) o[d_][r] *= al_l[crow(r, hi)]; } } while (0)

template <int MODE>
__device__ __forceinline__ void attn_pass(char* lds, const bf16x8 (&qr)[8], const bf16* K, const bf16* V, int t_lo, int t_hi, int posq, int qlo, unsigned sel, int own, f32x16 (&o)[4], float& l_out) {
    const int tid = opaque_tid(), lane = tid & 63, r32 = lane & 31, hi = lane >> 5, wid = __builtin_amdgcn_readfirstlane(tid >> 6);
    char* V_lds = lds + L_V; char* K_lds = lds + L_K;
    float* al_l = (float*)(lds + L_WS) + wid * 64 + 32;
    const int sr = tid >> 4, sc = (tid & 15) * 8, vst0 = v_st(sr, sc), vst1 = v_st(32 + sr, sc), kws = KSWZ(sr, sc * 2);
    const int vbase = (int)(uintptr_t)V_lds + v_rd_base(lane);
    float m_reg = -1e30f, l_reg = 0.f;
#pragma unroll
    for (int d = 0; d < 4; ++d) o[d] = f32x16{};
    Stage S;
    stage_load(S, K, V, t_lo * 64, sr, sc);
    stage_write(S, K_lds, V_lds, kws, vst0, vst1);
    __syncthreads();
    const int NT = t_hi - t_lo;
    for (int i = 0; i < NT; ++i) {
        const int t = t_lo + i, cur = i & 1, kb = t * 64;
        if (i + 1 < NT) stage_load(S, K, V, kb + 64, sr, sc);
        bool rowok = true, elem = false, act = true; unsigned W = WBIG;
        if (MODE == 0) { const int j = t >> 2; if (j < own) { rowok = (sel >> j) & 1u; act = __any(rowok); } else { elem = kb + 63 > qlo; act = kb <= qlo + 31; } }
        if (MODE == 2) { if (t < own) { rowok = (sel >> t) & 1u; act = __any(rowok); } else elem = true; }
        if (MODE == 3) { W = 512u; elem = (t == own) || (t == own - 8); }
        if (act) {
            f32x16 p0, p1;
            qkt(p0, p1, K_lds + cur * SHM_K, r32, hi, qr);
            if (elem) mask_tile(p0, p1, posq - kb - 4 * hi, W);
            bf16x8 pa0, pa1, pa2, pa3;
            const float alpha = softmax_tile(p0, p1, m_reg, l_reg, rowok, pa0, pa1, pa2, pa3);
            RESC(alpha);
            pv_tile(o, vbase + cur * SHM_V, pa0, pa1, pa2, pa3);
        }
        if (i + 1 < NT) stage_write(S, K_lds + (cur ^ 1) * SHM_K, V_lds + (cur ^ 1) * SHM_V, kws, vst0, vst1);
        __syncthreads();
    }
    l_out = l_reg;
}
#define ROW_RLI(lval) do { if (hi == 0) li_l[r32] = (lval); asm volatile("s_waitcnt lgkmcnt(0)" ::: "memory"); \
        _Pragma("unroll") for (int r = 0; r < 16; ++r) { const float lv_ = li_l[crow(r, hi)]; rli[r] = lv_ > 0.f ? __builtin_amdgcn_rcpf(lv_) : 0.f; } asm volatile("s_waitcnt lgkmcnt(0)" ::: "memory"); } while (0)

__device__ __forceinline__ void moba_item(const Bufs& bf, char* lds, int bh, int own) {
    const int tid = opaque_tid(), lane = tid & 63, r32 = lane & 31, hi = lane >> 5, wid = __builtin_amdgcn_readfirstlane(tid >> 6);
    const int b = bh >> 3, h = bh & 7, qlo = own * 256 + wid * 32, posq = qlo + r32;
    float* li_l = (float*)(lds + L_WS) + wid * 64;
    const bf16* Q = bf.b16(WS_QM) + ((size_t)bh * SEQ + posq) * HD; const bf16* K = bf.b16(WS_KM) + (size_t)bh * SEQ * HD; const bf16* V = bf.b16(WS_VM) + (size_t)bh * SEQ * HD;
    bf16x8 qr[8];
#pragma unroll
    for (int d0 = 0; d0 < 8; ++d0) qr[d0] = *(const bf16x8*)(Q + d0 * 16 + hi * 8);
    unsigned sel = 0u;
    if (own > 0) {
        char* K_lds = lds + L_K;
        if (tid < 256) {
            const int row = tid >> 4, c8 = (tid & 15) * 8; const float* src = bf.f32(WS_KMS) + ((size_t)bh * 8 + (row & 7)) * 128 + c8;
            const f32x4 a = *(const f32x4*)src, c = *(const f32x4*)(src + 4); float v[8] = {a[0], a[1], a[2], a[3], c[0], c[1], c[2], c[3]};
            if (row >= 8) {
#pragma unroll
                for (int j = 0; j < 8; ++j) v[j] = v[j] - bf2f(f2bf(v[j])); }
            u32x4 w; w.x = pk2(v[0], v[1]); w.y = pk2(v[2], v[3]); w.z = pk2(v[4], v[5]); w.w = pk2(v[6], v[7]);
            *(u32x4*)(K_lds + KSWZ(row, c8 * 2)) = w;
        }
        __syncthreads();
        f32x16 gp; qkt_half(gp, K_lds, r32, hi, qr);
        float gm[4], go[4], g[8];
#pragma unroll
        for (int j = 0; j < 4; ++j) gm[j] = gp[j] + gp[4 + j];
#pragma unroll
        for (int j = 0; j < 4; ++j) go[j] = __shfl_xor(gm[j], 32);
#pragma unroll
        for (int j = 0; j < 4; ++j) { g[j] = hi ? go[j] : gm[j]; g[4 + j] = hi ? gm[j] : go[j]; }
#pragma unroll
        for (int j = 0; j < 8; ++j) { int rank = 0;
#pragma unroll
            for (int k = 0; k < 8; ++k) if (k != j) rank += (k < own && (g[k] > g[j] || (g[k] == g[j] && k < j))) ? 1 : 0;
            if (j < own && rank < 3) sel |= 1u << j; }
        __syncthreads();
    }
    f32x16 o[4]; float l;
    attn_pass<0>(lds, qr, K, V, 0, 4 * own + 4, posq, qlo, sel, own, o, l);
    float rli[16]; ROW_RLI(l);
    const size_t tok0 = (size_t)b * SEQ + own * 256 + wid * 32;
    const bf16* GZ = bf.b16(WS_GZ); bf16* T = bf.b16(WS_T);
#pragma unroll
    for (int r = 0; r < 16; ++r) { const size_t base = (tok0 + crow(r, hi)) * 2048 + h * 128 + r32;
#pragma unroll
        for (int d0 = 0; d0 < 4; ++d0) { const float v = o[d0][r] * rli[r]; const float vn = __shfl_xor(v, 1);
            if ((r32 & 1) == 0) { const unsigned gz = *(const unsigned*)(GZ + base + d0 * 32); *(unsigned*)(T + base + d0 * 32) = cvtpk(v * bf2f(gz & 0xffffu), vn * bf2f(gz >> 16)); } } }
}

__device__ __forceinline__ void nsa_item(const Bufs& bf, char* lds, int bg, int own) {
    const int tid = opaque_tid(), lane = tid & 63, r32 = lane & 31, hi = lane >> 5, wid = __builtin_amdgcn_readfirstlane(tid >> 6);
    const int b = bg >> 1, g = bg & 1, headr = wid >> 1, head = 4 * g + headr, qq = 32 * (wid & 1) + r32, qlo = 64 * own + 32 * (wid & 1), posq = qlo + r32;
    char* V_lds = lds + L_V; char* K_lds = lds + L_K;
    float* li_l = (float*)(lds + L_WS) + wid * 64;
    float* impb = (float*)(lds + L_IMP); float* scoreb = (float*)(lds + L_SCORE); unsigned* selb = (unsigned*)(lds + L_SEL);
    const int sr = tid >> 4, sc = (tid & 15) * 8, vst0 = v_st(sr, sc), vst1 = v_st(32 + sr, sc), kws = KSWZ(sr, sc * 2);
    const int vbase = (int)(uintptr_t)V_lds + v_rd_base(lane);
    const size_t tok0 = (size_t)b * SEQ + qlo;
    const float* GT = bf.f32(WS_GATES) + (g * 4 + headr) * 3;
    bf16x8 qr[8]; f32x16 o[4]; float rli[16];
    {
        const bf16* KC = bf.b16(WS_KC) + (size_t)bg * 128 * HD; const bf16* VC = bf.b16(WS_VC) + (size_t)bg * 128 * HD;
        const bf16* Q = bf.b16(WS_NQRAW) + ((size_t)(b * 8 + head) * SEQ + posq) * HD;
#pragma unroll
        for (int d0 = 0; d0 < 8; ++d0) qr[d0] = *(const bf16x8*)(Q + d0 * 16 + hi * 8);
        { Stage S0, S1; stage_load(S0, KC, VC, 0, sr, sc); stage_load(S1, KC, VC, 64, sr, sc);
          stage_write(S0, K_lds, V_lds, kws, vst0, vst1); stage_write(S1, K_lds + SHM_K, V_lds + SHM_V, kws, vst0, vst1); }
        __syncthreads();
        f32x16 pA0, pA1, pB0, pB1;
        qkt(pA0, pA1, K_lds, r32, hi, qr); qkt(pB0, pB1, K_lds + SHM_K, r32, hi, qr);
        const int nmax = (posq - 31) >> 4;
        mask_tile(pA0, pA1, nmax - 4 * hi, WBIG); mask_tile(pB0, pB1, nmax - 64 - 4 * hi, WBIG);
        float pmax = pA0[0];
#pragma unroll
        for (int r = 0; r < 16; ++r) pmax = fmaxf(fmaxf(pmax, pA0[r]), fmaxf(pA1[r], fmaxf(pB0[r], pB1[r])));
        { auto rr = __builtin_amdgcn_permlane32_swap(__float_as_uint(pmax), __float_as_uint(pmax), false, false); pmax = fmaxf(__uint_as_float(rr[0]), __uint_as_float(rr[1])); }
        const float mnL = (pmax == -__builtin_inff()) ? 0.f : -pmax * C2;
        float ps = 0.f;
#pragma unroll
        for (int r = 0; r < 16; ++r) { pA0[r] = __builtin_amdgcn_exp2f(fmaf(pA0[r], C2, mnL)); pA1[r] = __builtin_amdgcn_exp2f(fmaf(pA1[r], C2, mnL));
            pB0[r] = __builtin_amdgcn_exp2f(fmaf(pB0[r], C2, mnL)); pB1[r] = __builtin_amdgcn_exp2f(fmaf(pB1[r], C2, mnL)); ps += (pA0[r] + pA1[r]) + (pB0[r] + pB1[r]); }
        { auto rr = __builtin_amdgcn_permlane32_swap(__float_as_uint(ps), __float_as_uint(ps), false, false); ps = __uint_as_float(rr[0]) + __uint_as_float(rr[1]); }
        const float rl = ps > 0.f ? 1.f / ps : 0.f;
        {
            float G[16], L[16], Lo[16];
#pragma unroll
            for (int q4 = 0; q4 < 4; ++q4) {
                G[q4] = ((pA0[4 * q4] + pA0[4 * q4 + 1]) + (pA0[4 * q4 + 2] + pA0[4 * q4 + 3])) * rl; L[q4] = pA0[4 * q4 + 3] * rl;
                G[4 + q4] = ((pA1[4 * q4] + pA1[4 * q4 + 1]) + (pA1[4 * q4 + 2] + pA1[4 * q4 + 3])) * rl; L[4 + q4] = pA1[4 * q4 + 3] * rl;
                G[8 + q4] = ((pB0[4 * q4] + pB0[4 * q4 + 1]) + (pB0[4 * q4 + 2] + pB0[4 * q4 + 3])) * rl; L[8 + q4] = pB0[4 * q4 + 3] * rl;
                G[12 + q4] = ((pB1[4 * q4] + pB1[4 * q4 + 1]) + (pB1[4 * q4 + 2] + pB1[4 * q4 + 3])) * rl; L[12 + q4] = pB1[4 * q4 + 3] * rl; }
#pragma unroll
            for (int i = 0; i < 16; ++i) Lo[i] = __shfl_xor(L[i], 32);
            float* ib = impb + ((size_t)headr * 64 + qq) * 32 + hi;
#pragma unroll
            for (int i = 0; i < 16; ++i) { const float prev = hi ? Lo[i] : (i > 0 ? Lo[i > 0 ? i - 1 : 0] : 0.f); ib[2 * i] = G[i] + prev; }
        }
        bf16x8 pa0, pa1, pa2, pa3, pb0, pb1, pb2, pb3;
        PK4(pA0, 0, pa0); PK4(pA0, 8, pa1); PK4(pA1, 0, pa2); PK4(pA1, 8, pa3);
        PK4(pB0, 0, pb0); PK4(pB0, 8, pb1); PK4(pB1, 0, pb2); PK4(pB1, 8, pb3);
#pragma unroll
        for (int d = 0; d < 4; ++d) o[d] = f32x16{};
        pv_tile(o, vbase, pa0, pa1, pa2, pa3); pv_tile(o, vbase + SHM_V, pb0, pb1, pb2, pb3);
        if (hi == 0) li_l[r32] = rl; asm volatile("s_waitcnt lgkmcnt(0)" ::: "memory");
#pragma unroll
        for (int r = 0; r < 16; ++r) { const int rw = crow(r, hi); const float f = li_l[rw] * GT[(tok0 + rw) * 24 + 0];
#pragma unroll
            for (int d0 = 0; d0 < 4; ++d0) o[d0][r] *= f; }
        asm volatile("s_waitcnt lgkmcnt(0)" ::: "memory");
    }
    __syncthreads();
    {
        const int qs = tid >> 3, jg = tid & 7; float s4[4];
#pragma unroll
        for (int jj = 0; jj < 4; ++jj) { const int j = 4 * jg + jj;
            float s = ((impb[(0 * 64 + qs) * 32 + j] + impb[(1 * 64 + qs) * 32 + j]) + impb[(2 * 64 + qs) * 32 + j]) + impb[(3 * 64 + qs) * 32 + j];
            if (j > own) s = -__builtin_inff(); else if (j == 0 || j == own || j == own - 1) s = __builtin_inff();
            s4[jj] = s; scoreb[qs * 32 + j] = s; }
        __syncthreads();
        unsigned bits = 0u;
#pragma unroll
        for (int jj = 0; jj < 4; ++jj) { const int j = 4 * jg + jj; const float s = s4[jj]; int rank = 0;
            for (int k = 0; k < 32; ++k) { const float sk = scoreb[qs * 32 + k]; rank += (sk > s || (sk == s && k < j)) ? 1 : 0; }
            if (rank < 8 && s > -__builtin_inff()) bits |= 1u << j; }
        bits |= __shfl_xor(bits, 1); bits |= __shfl_xor(bits, 2); bits |= __shfl_xor(bits, 4);
        if (jg == 0) selb[qs] = bits;
        __syncthreads();
    }
    const unsigned sel = selb[qq];
    char* accp = lds + L_ACC + tid * 16;
#pragma unroll
    for (int q = 0; q < 8; ++q) { const int d0 = q >> 1, r0 = 8 * (q & 1);
        u32x4 w; w.x = cvtpk(o[d0][r0], o[d0][r0 + 1]); w.y = cvtpk(o[d0][r0 + 2], o[d0][r0 + 3]); w.z = cvtpk(o[d0][r0 + 4], o[d0][r0 + 5]); w.w = cvtpk(o[d0][r0 + 6], o[d0][r0 + 7]);
        *(u32x4*)(accp + q * 8192) = w; }
    {
        const bf16* Q = bf.b16(WS_NQROT) + ((size_t)(b * 8 + head) * SEQ + posq) * HD;
#pragma unroll
        for (int d0 = 0; d0 < 8; ++d0) qr[d0] = *(const bf16x8*)(Q + d0 * 16 + hi * 8);
        float l;
        attn_pass<2>(lds, qr, bf.b16(WS_KS) + (size_t)bg * SEQ * HD, bf.b16(WS_VS) + (size_t)bg * SEQ * HD, 0, own + 1, posq, qlo, sel, own, o, l);
        ROW_RLI(l);
#pragma unroll
        for (int r = 0; r < 16; ++r) rli[r] *= GT[(tok0 + crow(r, hi)) * 24 + 1];
#pragma unroll
        for (int q = 0; q < 8; ++q) { const int d0 = q >> 1, r0 = 8 * (q & 1);
            const u32x4 a = *(const u32x4*)(accp + q * 8192); const unsigned aw[4] = {a.x, a.y, a.z, a.w}; unsigned ow[4];
#pragma unroll
            for (int k = 0; k < 4; ++k) ow[k] = cvtpk(bf2f(aw[k] & 0xffffu) + o[d0][r0 + 2 * k] * rli[r0 + 2 * k], bf2f(aw[k] >> 16) + o[d0][r0 + 2 * k + 1] * rli[r0 + 2 * k + 1]);
            *(u32x4*)(accp + q * 8192) = (u32x4){ow[0], ow[1], ow[2], ow[3]}; }
    }
    {
        float l;
        attn_pass<3>(lds, qr, bf.b16(WS_KW) + (size_t)bg * SEQ * HD, bf.b16(WS_VW) + (size_t)bg * SEQ * HD, own > 8 ? own - 8 : 0, own + 1, posq, qlo, 0u, own, o, l);
        ROW_RLI(l);
        const bf16* GZ = bf.b16(WS_GZ); bf16* T = bf.b16(WS_T);
#pragma unroll
        for (int r = 0; r < 16; ++r) rli[r] *= GT[(tok0 + crow(r, hi)) * 24 + 2];
#pragma unroll
        for (int q = 0; q < 8; ++q) { const int d0 = q >> 1, r0 = 8 * (q & 1);
            const u32x4 a = *(const u32x4*)(accp + q * 8192); const unsigned aw[4] = {a.x, a.y, a.z, a.w};
#pragma unroll
            for (int k = 0; k < 8; ++k) { const int r = r0 + k; const float av = (k & 1) ? bf2f(aw[k >> 1] >> 16) : bf2f(aw[k >> 1] & 0xffffu);
                const float v = av + o[d0][r] * rli[r]; const float vn = __shfl_xor(v, 1);
                const size_t base = (tok0 + crow(r, hi)) * 2048 + 1024 + head * 128 + d0 * 32 + r32;
                if ((r32 & 1) == 0) { const unsigned gz = *(const unsigned*)(GZ + base); *(unsigned*)(T + base) = cvtpk(v * bf2f(gz & 0xffffu), vn * bf2f(gz >> 16)); } } }
    }
}

struct ItemTable { unsigned short v[1024]; };
constexpr int moba_cost(int own) { return 4 * (own + 1) + 1; }
constexpr int nsa_cost(int own) { return 3 + (own + 1) + ((own + 1) < 9 ? (own + 1) : 9); }
constexpr ItemTable make_items() {
    ItemTable t{}; int n = 0;
    for (int c = 64; c >= 0; --c) {
        for (int own = 0; own < 8; ++own) if (moba_cost(own) == c) for (int bh = 0; bh < 64; ++bh) t.v[n++] = (unsigned short)((bh << 3) | own);
        for (int own = 0; own < 32; ++own) if (nsa_cost(own) == c) for (int bg = 0; bg < 16; ++bg) t.v[n++] = (unsigned short)(0x8000 | (bg << 5) | own);
    }
    return t;
}
__device__ const ItemTable ITEMS = make_items();

__device__ __forceinline__ void attn_phase(const Bufs& bf, char* lds) {
    const int tid = threadIdx.x;
    volatile int* itemw = (volatile int*)(lds + L_ITEM);
    unsigned* ctr = (unsigned*)(bf.ws + WS_CTL) + 64;
    for (;;) {
        if (tid == 0) *itemw = (int)atomicAdd(ctr, 1u);
        __syncthreads();
        const int it = __builtin_amdgcn_readfirstlane(*itemw);
        __syncthreads();
        if (it >= 1024) break;
        const unsigned e = ITEMS.v[it];
        if (e & 0x8000u) nsa_item(bf, lds, (int)((e >> 5) & 15u), (int)(e & 31u)); else moba_item(bf, lds, (int)((e >> 3) & 63u), (int)(e & 7u));
    }
}
#undef RESC
#undef ROW_RLI
#undef PK4
#undef KSWZ
#undef SBAR
}

__global__ void __launch_bounds__(256) naive_inproj(Bufs Bf) {
    __shared__ float hs[16][64];
    const int tid = threadIdx.x, dd = tid & 63, u = blockIdx.x * 4 + (tid >> 6), row0 = blockIdx.y * 16;
    const bool uv = u < 61;
    const int cb = !uv ? 0 : (u < 52 ? 128 * u : (u < 60 ? C_NZ + 128 * (u - 52) : C_NG));
    const bool v1ok = uv && (u < 60 || dd < 24), v2ok = uv && u < 60;
    const int c1 = cb + dd, c2 = cb + dd + 64;
    float a1[16], a2[16];
#pragma unroll
    for (int r = 0; r < 16; ++r) { a1[r] = 0.f; a2[r] = 0.f; }
    const bf16* H = Bf.b16(WS_H);
    for (int k0 = 0; k0 < 2048; k0 += 64) {
        __syncthreads();
        for (int i = tid; i < 16 * 64; i += 256) hs[i >> 6][i & 63] = bf2f(H[(size_t)(row0 + (i >> 6)) * 2048 + k0 + (i & 63)]);
        __syncthreads();
        for (int k = 0; k < 64; ++k) {
            const float w1 = v1ok ? Bf.w_in[(size_t)(k0 + k) * INC + c1] : 0.f, w2 = v2ok ? Bf.w_in[(size_t)(k0 + k) * INC + c2] : 0.f;
#pragma unroll
            for (int r = 0; r < 16; ++r) { const float h = hs[r][k]; a1[r] += h * w1; a2[r] += h * w2; }
        }
    }
    if (!uv) return;
    const float* COS = Bf.f32(WS_COS); const float* SIN = Bf.f32(WS_SIN);
    for (int r = 0; r < 16; ++r) {
        const int row = row0 + r, b = row >> 11, s = row & 2047; float v1 = a1[r], v2 = a2[r];
        bf16* dst = nullptr; int nh = 8, head = 0; bool rope = false; bf16* dst_raw = nullptr;
        if (u < 8) { dst = Bf.b16(WS_QM); head = u; rope = true; }
        else if (u < 16) { dst = Bf.b16(WS_KM); head = u - 8; rope = true; }
        else if (u < 24) { dst = Bf.b16(WS_VM); head = u - 16; }
        else if (u < 32) { bf16* gz = Bf.b16(WS_GZ) + (size_t)row * 2048 + (u - 24) * 128; gz[dd] = (bf16)f2bf(silu_f(v1)); gz[dd + 64] = (bf16)f2bf(silu_f(v2)); continue; }
        else if (u < 40) { dst = Bf.b16(WS_NQROT); dst_raw = Bf.b16(WS_NQRAW); head = u - 32; rope = true; }
        else if (u < 42) { dst = Bf.b16(WS_KCIN); head = u - 40; nh = 2; }
        else if (u < 44) { dst = Bf.b16(WS_VCIN); head = u - 42; nh = 2; }
        else if (u < 46) { dst = Bf.b16(WS_KS); head = u - 44; nh = 2; rope = true; }
        else if (u < 48) { dst = Bf.b16(WS_VS); head = u - 46; nh = 2; }
        else if (u < 50) { dst = Bf.b16(WS_KW); head = u - 48; nh = 2; rope = true; }
        else if (u < 52) { dst = Bf.b16(WS_VW); head = u - 50; nh = 2; }
        else if (u < 60) { bf16* gz = Bf.b16(WS_GZ) + (size_t)row * 2048 + 1024 + (u - 52) * 128; gz[dd] = (bf16)f2bf(silu_f(v1)); gz[dd + 64] = (bf16)f2bf(silu_f(v2)); continue; }
        else { if (dd < 24) Bf.f32(WS_GATES)[(size_t)row * 24 + dd] = sigmoid_f(v1); continue; }
        const size_t o = ((size_t)(b * nh + head) * SEQ + s) * HD + dd;
        if (dst_raw) { dst_raw[o] = (bf16)f2bf(v1); dst_raw[o + 64] = (bf16)f2bf(v2); }
        if (rope) { const float c = COS[(size_t)row * 64 + dd], sn = SIN[(size_t)row * 64 + dd]; const float o1 = v1 * c - v2 * sn, o2 = v2 * c + v1 * sn; v1 = o1; v2 = o2; }
        dst[o] = (bf16)f2bf(v1); dst[o + 64] = (bf16)f2bf(v2);
    }
}
__global__ void __launch_bounds__(256) naive_kmean(Bufs Bf) {
    const int i = blockIdx.x * 256 + threadIdx.x; if (i >= 8 * 8 * 8 * 128) return;
    const int d = i & 127, blk = (i >> 7) & 7, bh = i >> 10;
    const bf16* K = Bf.b16(WS_KM) + ((size_t)bh * SEQ + blk * 256) * HD + d; float s = 0.f;
    for (int r = 0; r < 256; ++r) s += bf2f(K[(size_t)r * HD]);
    Bf.f32(WS_KMS)[i] = s;
}
__global__ void __launch_bounds__(256) naive_compress(Bufs Bf) {
    __shared__ float in[4096]; __shared__ float hid[256];
    const int i = blockIdx.x, bg = blockIdx.y, kv = blockIdx.z, tid = threadIdx.x;
    bf16* outp = Bf.b16(kv ? WS_VC : WS_KC) + ((size_t)bg * 128 + i) * 128;
    if (i == 127) { if (tid < 128) outp[tid] = 0; return; }
    const bf16* src = Bf.b16(kv ? WS_VCIN : WS_KCIN) + ((size_t)bg * SEQ + 16 * i) * HD;
    const float* pe = kv ? Bf.pe_cv : Bf.pe_ck; const float* w1 = kv ? Bf.w_cv1 : Bf.w_ck1; const float* w2 = kv ? Bf.w_cv2 : Bf.w_ck2;
    for (int k = tid; k < 4096; k += 256) in[k] = bf2f(src[k]) + pe[k];
    __syncthreads();
    float a = 0.f;
    for (int k = 0; k < 4096; ++k) a += in[k] * w1[(size_t)k * 256 + tid];
    hid[tid] = silu_f(a);
    __syncthreads();
    if (tid < 128) { float o = 0.f; for (int n = 0; n < 256; ++n) o += hid[n] * w2[n * 128 + tid]; outp[tid] = (bf16)f2bf(o); }
}

#define WAVE_LDS_SYNC() asm volatile("s_waitcnt lgkmcnt(0)" ::: "memory")
__device__ __forceinline__ void na_load_q(const bf16* q, float* qf, int lane) { qf[lane] = bf2f(q[lane]); qf[lane + 64] = bf2f(q[lane + 64]); WAVE_LDS_SYNC(); }
__device__ __forceinline__ void na_scores(const float* qf, const bf16* K, int kb, bool valid, int lane, float* sc, int* kidx, int& n) {
    float s = -__builtin_inff();
    if (valid) { const bf16* kr = K + (size_t)(kb + lane) * HD; float a = 0.f;
        for (int d = 0; d < 128; d += 8) { const u32x4 w = *(const u32x4*)(kr + d);
            a += qf[d] * bf2f(w.x & 0xffffu) + qf[d + 1] * bf2f(w.x >> 16) + qf[d + 2] * bf2f(w.y & 0xffffu) + qf[d + 3] * bf2f(w.y >> 16)
               + qf[d + 4] * bf2f(w.z & 0xffffu) + qf[d + 5] * bf2f(w.z >> 16) + qf[d + 6] * bf2f(w.w & 0xffffu) + qf[d + 7] * bf2f(w.w >> 16); }
        s = a * SCALE; }
    sc[n + lane] = s; kidx[n + lane] = kb + lane; n += 64;
}
__device__ __forceinline__ float na_finish(float* sc, const int* kidx, int n, const bf16* V, int lane, float& o0, float& o1) {
    WAVE_LDS_SYNC();
    float m = -__builtin_inff();
    for (int i = lane; i < n; i += 64) m = fmaxf(m, sc[i]);
    m = wave_max(m);
    if (m == -__builtin_inff()) { o0 = 0.f; o1 = 0.f; return 0.f; }
    float l = 0.f;
    for (int i = lane; i < n; i += 64) { const float p = __expf(sc[i] - m); sc[i] = p; l += p; }
    l = wave_sum(l);
    WAVE_LDS_SYNC();
    float a0 = 0.f, a1 = 0.f;
    for (int i = 0; i < n; ++i) { const float p = sc[i]; if (p != 0.f) { const bf16* vr = V + (size_t)kidx[i] * HD; a0 += p * bf2f(vr[lane]); a1 += p * bf2f(vr[lane + 64]); } }
    const float rl = 1.f / l; o0 = a0 * rl; o1 = a1 * rl; return l;
}
__global__ void __launch_bounds__(256) naive_moba(Bufs Bf) {
    __shared__ float sc_[4][1024]; __shared__ int kx_[4][1024]; __shared__ float qf_[4][128];
    const int w = threadIdx.x >> 6, lane = threadIdx.x & 63;
    const int q = blockIdx.x * 4 + w, bh = blockIdx.y, b = bh >> 3, h = bh & 7;
    float* sc = sc_[w]; int* kidx = kx_[w]; float* qf = qf_[w];
    const bf16* Q = Bf.b16(WS_QM) + ((size_t)bh * SEQ + q) * HD; const bf16* K = Bf.b16(WS_KM) + (size_t)bh * SEQ * HD; const bf16* V = Bf.b16(WS_VM) + (size_t)bh * SEQ * HD;
    na_load_q(Q, qf, lane);
    const int own = q >> 8;
    float g = -__builtin_inff();
    if (lane < own) { const float* km = Bf.f32(WS_KMS) + ((size_t)bh * 8 + lane) * 128; float a = 0.f; for (int d = 0; d < 128; ++d) a += qf[d] * km[d]; g = a; }
    int rank = 0;
    for (int k = 0; k < 8; ++k) { const float gk = __shfl(g, k); rank += (gk > g || (gk == g && k < lane)) ? 1 : 0; }
    const bool sel = (lane < own) && rank < 3;
    const unsigned long long selm = __ballot(sel);
    int n = 0;
    for (int j = 0; j < own; ++j) if ((selm >> j) & 1ull) for (int c = 0; c < 4; ++c) na_scores(qf, K, j * 256 + c * 64, true, lane, sc, kidx, n);
    for (int c = 0; c < 4; ++c) { const int kb = own * 256 + c * 64; if (kb <= q) na_scores(qf, K, kb, kb + lane <= q, lane, sc, kidx, n); }
    float o0, o1; na_finish(sc, kidx, n, V, lane, o0, o1);
    const int row = b * SEQ + q; const bf16* gz = Bf.b16(WS_GZ) + (size_t)row * 2048 + h * 128; bf16* T = Bf.b16(WS_T) + (size_t)row * 2048 + h * 128;
    T[lane] = (bf16)f2bf(o0 * bf2f(gz[lane])); T[lane + 64] = (bf16)f2bf(o1 * bf2f(gz[lane + 64]));
}
__global__ void __launch_bounds__(128) naive_nsa(Bufs Bf) {
    __shared__ float sc_[2][640]; __shared__ int kx_[2][640]; __shared__ float qf_[2][128];
    const int w = threadIdx.x >> 6, lane = threadIdx.x & 63;
    const int q = blockIdx.x * 2 + w, bg = blockIdx.y, b = bg >> 1, g = bg & 1;
    float* sc = sc_[w]; int* kidx = kx_[w]; float* qf = qf_[w];
    const int row = b * SEQ + q, own = q >> 6;
    const bf16* KC = Bf.b16(WS_KC) + (size_t)bg * 128 * HD; const bf16* VC = Bf.b16(WS_VC) + (size_t)bg * 128 * HD;
    const bf16* KS = Bf.b16(WS_KS) + (size_t)bg * SEQ * HD; const bf16* VS = Bf.b16(WS_VS) + (size_t)bg * SEQ * HD;
    const bf16* KW = Bf.b16(WS_KW) + (size_t)bg * SEQ * HD; const bf16* VW = Bf.b16(WS_VW) + (size_t)bg * SEQ * HD;
    float oc0[4], oc1[4]; float imp = 0.f;
    for (int r = 0; r < 4; ++r) {
        const int head = g * 4 + r;
        na_load_q(Bf.b16(WS_NQRAW) + ((size_t)(b * 8 + head) * SEQ + q) * HD, qf, lane);
        int n = 0;
        for (int c = 0; c < 2; ++c) { const int key = c * 64 + lane; na_scores(qf, KC, c * 64, key < 127 && 16 * key + 31 <= q, lane, sc, kidx, n); }
        const float l = na_finish(sc, kidx, n, VC, lane, oc0[r], oc1[r]);
        if (l > 0.f && lane < 32) { const float rl = 1.f / l; float a = 0.f;
            for (int t = 4 * lane - 1; t <= 4 * lane + 3; ++t) if (t >= 0 && t < 127) a += sc[t] * rl;
            imp += a; }
        WAVE_LDS_SYNC();
    }
    float s = -__builtin_inff();
    if (lane < 32) { if (lane > own) s = -__builtin_inff(); else if (lane == 0 || lane == own || lane == own - 1) s = __builtin_inff(); else s = imp; }
    int rank = 0;
    for (int k = 0; k < 32; ++k) { const float sk = __shfl(s, k); rank += (sk > s || (sk == s && k < lane)) ? 1 : 0; }
    const bool sel = lane < 32 && rank < 8 && s > -__builtin_inff();
    const unsigned long long selm = __ballot(sel);
    const float* gt = Bf.f32(WS_GATES) + (size_t)row * 24 + g * 12;
    for (int r = 0; r < 4; ++r) {
        const int head = g * 4 + r;
        na_load_q(Bf.b16(WS_NQROT) + ((size_t)(b * 8 + head) * SEQ + q) * HD, qf, lane);
        int n = 0;
        for (int j = 0; j < 32; ++j) if ((selm >> j) & 1ull) na_scores(qf, KS, j * 64, j * 64 + lane <= q, lane, sc, kidx, n);
        float os0, os1; na_finish(sc, kidx, n, VS, lane, os0, os1);
        WAVE_LDS_SYNC();
        n = 0;
        const int lo = q - 511 > 0 ? q - 511 : 0;
        for (int kb = (lo >> 6) << 6; kb <= q; kb += 64) { const int key = kb + lane; na_scores(qf, KW, kb, key <= q && key > q - 512, lane, sc, kidx, n); }
        float ow0, ow1; na_finish(sc, kidx, n, VW, lane, ow0, ow1);
        WAVE_LDS_SYNC();
        const float g0 = gt[r * 3 + 0], g1 = gt[r * 3 + 1], g2 = gt[r * 3 + 2];
        const float v0 = g0 * oc0[r] + g1 * os0 + g2 * ow0, v1 = g0 * oc1[r] + g1 * os1 + g2 * ow1;
        const bf16* gz = Bf.b16(WS_GZ) + (size_t)row * 2048 + 1024 + head * 128; bf16* T = Bf.b16(WS_T) + (size_t)row * 2048 + 1024 + head * 128;
        T[lane] = (bf16)f2bf(v0 * bf2f(gz[lane])); T[lane + 64] = (bf16)f2bf(v1 * bf2f(gz[lane + 64]));
    }
}
__global__ void __launch_bounds__(256) naive_tnorm(Bufs Bf) {
    const int lane = threadIdx.x & 63, row = blockIdx.x * 4 + (threadIdx.x >> 6);
    bf16* T = Bf.b16(WS_T) + (size_t)row * 2048;
    for (int half = 0; half < 2; ++half) {
        bf16* p = T + half * 1024 + lane * 16; u32x4 a = *(u32x4*)p, c = *(u32x4*)(p + 8); unsigned w[8] = {a.x, a.y, a.z, a.w, c.x, c.y, c.z, c.w};
        float s = 0.f;
#pragma unroll
        for (int i = 0; i < 8; ++i) { const float lo = bf2f(w[i] & 0xffffu), hi = bf2f(w[i] >> 16); s += lo * lo + hi * hi; }
        const float rstd = 1.0f / sqrtf(wave_sum(s) * (1.f / 1024.f) + EPS);
#pragma unroll
        for (int i = 0; i < 8; ++i) w[i] = pk2(bf2f(w[i] & 0xffffu) * rstd, bf2f(w[i] >> 16) * rstd);
        *(u32x4*)p = (u32x4){w[0], w[1], w[2], w[3]}; *(u32x4*)(p + 8) = (u32x4){w[4], w[5], w[6], w[7]};
    }
}
__global__ void __launch_bounds__(256) naive_outproj(Bufs Bf) {
    __shared__ float ys[16][64];
    const int tid = threadIdx.x, col = blockIdx.x * 256 + tid, row0 = blockIdx.y * 16;
    float a[16];
#pragma unroll
    for (int r = 0; r < 16; ++r) a[r] = 0.f;
    const bf16* T = Bf.b16(WS_T);
    for (int k0 = 0; k0 < 2048; k0 += 64) {
        __syncthreads();
        for (int i = tid; i < 16 * 64; i += 256) ys[i >> 6][i & 63] = bf2f(T[(size_t)(row0 + (i >> 6)) * 2048 + k0 + (i & 63)]);
        __syncthreads();
        for (int k = 0; k < 64; ++k) { const int e = k0 + k; const float w = Bf.w_out[(size_t)e * 2048 + col] * (e < 1024 ? Bf.g_out_moba[e] : Bf.g_out_nsa[e - 1024]);
#pragma unroll
            for (int r = 0; r < 16; ++r) a[r] += ys[r][k] * w; }
    }
    for (int r = 0; r < 16; ++r) { const size_t o = (size_t)(row0 + r) * 2048 + col; Bf.out[o] = Bf.x[o] + a[r]; }
}
__device__ __forceinline__ void final_norm_row(const Bufs& Bf, int m, int lane) {
    float* xr = Bf.out + (size_t)m * DM + lane * 8; f32x4 v[8]; float s = 0.f;
#pragma unroll
    for (int j = 0; j < 4; ++j) { v[2 * j] = *(const f32x4*)(xr + j * 512); v[2 * j + 1] = *(const f32x4*)(xr + j * 512 + 4); }
#pragma unroll
    for (int j = 0; j < 8; ++j) s += (v[j].x * v[j].x + v[j].y * v[j].y) + (v[j].z * v[j].z + v[j].w * v[j].w);
    const float rstd = 1.0f / sqrtf(wave_sum(s) * (1.f / DM) + EPS);
#pragma unroll
    for (int j = 0; j < 4; ++j) { const f32x4 g0 = *(const f32x4*)(Bf.g_final + j * 512 + lane * 8), g1 = *(const f32x4*)(Bf.g_final + j * 512 + lane * 8 + 4);
        *(f32x4*)(xr + j * 512) = v[2 * j] * rstd * g0; *(f32x4*)(xr + j * 512 + 4) = v[2 * j + 1] * rstd * g1; }
}
__global__ void __launch_bounds__(256) naive_final(Bufs Bf) { final_norm_row(Bf, blockIdx.x * 4 + (threadIdx.x >> 6), threadIdx.x & 63); }

constexpr int NWAVES = 8;
constexpr int LDS_BYTES = 147456;
struct Args { Bufs bf; int ph_lo, ph_hi; };
__global__ void __launch_bounds__(NWAVES * 64, 2) mk_fwd(Args args) {
    extern __shared__ __attribute__((aligned(16))) unsigned char lds[];
    const int tid = threadIdx.x, lane = tid & 63, wave = __builtin_amdgcn_readfirstlane(tid >> 6);
    const int G = gridDim.x, gw = blockIdx.x * NWAVES + wave, NGW = G * NWAVES;
    const int lo = args.ph_lo, hi = args.ph_hi;
    if (lo <= 0 && 0 < hi) p0_prologue(args.bf, gw, NGW, lane, (float*)(lds + wave * 16384));
    if (lo <= 1 && 1 < hi) {
        pg8::Gemm g{args.bf.b16(WS_H), args.bf.b16(WS_WINT), M, NPAD, 2048}; pg8::StaticOrder S; S.init(M, NPAD, G, (int)blockIdx.x);
        EpiIn E{args.bf};
        pg8::gemm_phase<EpiIn, pg8::StaticOrder, true, true>((PG8_LAS unsigned char*)lds, g, S, E);
    }
    if (lo <= 3 && 3 < hi) att::attn_phase(args.bf, (char*)lds);
    if (lo <= 5 && 5 < hi) {
        pg8::Gemm g{args.bf.b16(WS_T), args.bf.b16(WS_WOUTT), M, DM, 2048}; pg8::StaticOrder S; S.init(M, DM, G, (int)blockIdx.x);
        EpiOut E{args.bf.x, args.bf.out};
        pg8::gemm_phase<EpiOut, pg8::StaticOrder, true, true>((PG8_LAS unsigned char*)lds, g, S, E);
    }
}

extern "C" void kernel_launch(void* const* d_in, const int* in_sizes, int n_in, void* d_out, int out_size, void* d_ws, size_t ws_size, hipStream_t stream) {
    static int grid = 0;
    if (grid == 0) {
        if (n_in != 14 || in_sizes[0] != M * DM || out_size != M * DM || ws_size < WS_END) {
            fprintf(stderr, "kernel_launch: unexpected shapes: n_in %d in0 %d out %d ws %zu (need %zu)\n", n_in, n_in > 0 ? in_sizes[0] : -1, out_size, ws_size, (size_t)WS_END); grid = -1; return; }
        int dev = 0, cus = 0;
        if (hipGetDevice(&dev) != hipSuccess || hipDeviceGetAttribute(&cus, hipDeviceAttributeMultiprocessorCount, dev) != hipSuccess) { grid = -1; return; }
        if (hipFuncSetAttribute((const void*)mk_fwd, hipFuncAttributeMaxDynamicSharedMemorySize, LDS_BYTES) != hipSuccess) { fprintf(stderr, "kernel_launch: hipFuncSetAttribute failed\n"); grid = -1; return; }
        grid = cus;
    }
    if (grid < 0) return;
    (void)hipMemsetAsync((char*)d_ws + WS_CTL, 0, CTL_ZERO_BYTES, stream);
    Args a{};
    a.bf.x = (const float*)d_in[0]; a.bf.pos = (const int*)d_in[1]; a.bf.w_in = (const float*)d_in[2]; a.bf.g_norm = (const float*)d_in[3];
    a.bf.pe_ck = (const float*)d_in[4]; a.bf.pe_cv = (const float*)d_in[5]; a.bf.w_ck1 = (const float*)d_in[6]; a.bf.w_ck2 = (const float*)d_in[7];
    a.bf.w_cv1 = (const float*)d_in[8]; a.bf.w_cv2 = (const float*)d_in[9]; a.bf.g_out_moba = (const float*)d_in[10]; a.bf.g_out_nsa = (const float*)d_in[11];
    a.bf.w_out = (const float*)d_in[12]; a.bf.g_final = (const float*)d_in[13]; a.bf.out = (float*)d_out; a.bf.ws = (unsigned char*)d_ws;
    a.ph_lo = 0; a.ph_hi = 1;
    hipLaunchKernelGGL(mk_fwd, dim3(grid), dim3(NWAVES * 64), LDS_BYTES, stream, a);
    a.ph_lo = 1; a.ph_hi = 2; hipLaunchKernelGGL(mk_fwd, dim3(grid), dim3(NWAVES * 64), LDS_BYTES, stream, a);
    hipLaunchKernelGGL(naive_compress, dim3(128, 16, 2), dim3(256), 0, stream, a.bf);
    a.ph_lo = 3; a.ph_hi = 4; hipLaunchKernelGGL(mk_fwd, dim3(grid), dim3(NWAVES * 64), LDS_BYTES, stream, a);
    hipLaunchKernelGGL(naive_tnorm, dim3(M / 4), dim3(256), 0, stream, a.bf);
    a.ph_lo = 5; a.ph_hi = 6; hipLaunchKernelGGL(mk_fwd, dim3(grid), dim3(NWAVES * 64), LDS_BYTES, stream, a);
    hipLaunchKernelGGL(naive_final, dim3(M / 4), dim3(256), 0, stream, a.bf);
}
```

```cpp
#include <hip/hip_runtime.h>
#include <cstdio>
#include <cstdint>

constexpr int NB = 8, SEQ = 2048, DM = 2048, M = NB * SEQ;
constexpr int HD = 128;
constexpr int INC = 7704;
constexpr int C_NG = 6656, C_NZ = 6680;
constexpr float EPS = 1e-6f;
constexpr float SCALE = 0.08838834764831845f;
constexpr int NPAD = 7936;

typedef unsigned short bf16;
typedef short bf16x8 __attribute__((ext_vector_type(8)));
typedef float f32x4 __attribute__((ext_vector_type(4)));
typedef float f32x16 __attribute__((ext_vector_type(16)));
typedef unsigned u32x4 __attribute__((ext_vector_type(4)));
typedef unsigned u32x2 __attribute__((ext_vector_type(2)));

__device__ __forceinline__ unsigned f2bf(float f) { unsigned u = __builtin_bit_cast(unsigned, f); return (u + 0x7fffu + ((u >> 16) & 1u)) >> 16; }
__device__ __forceinline__ unsigned pk2(float lo, float hi) { return f2bf(lo) | (f2bf(hi) << 16); }
__device__ __forceinline__ float bf2f(unsigned b) { return __builtin_bit_cast(float, b << 16); }
__device__ __forceinline__ float silu_f(float v) { return v / (1.f + __expf(-v)); }
__device__ __forceinline__ float sigmoid_f(float v) { return 1.f / (1.f + __expf(-v)); }
__device__ __forceinline__ float wave_sum(float v) {
#pragma unroll
    for (int o = 1; o < 64; o <<= 1) v += __shfl_xor(v, o);
    return v;
}
__device__ __forceinline__ float wave_max(float v) {
#pragma unroll
    for (int o = 1; o < 64; o <<= 1) v = fmaxf(v, __shfl_xor(v, o));
    return v;
}

constexpr size_t MiB = 1u << 20;
constexpr size_t WS_CTL = 0, CTL_ZERO_BYTES = 1 * MiB;
constexpr size_t WS_KMS = 512 * 1024;
constexpr size_t WS_WINT = 2 * MiB;
constexpr size_t WS_WOUTT = 34 * MiB;
constexpr size_t WS_WC1T = 42 * MiB;
constexpr size_t WS_WC2T = 46 * MiB;
constexpr size_t WS_CBIAS = 46 * MiB + 256 * 1024;
constexpr size_t WS_KC = 46 * MiB + 512 * 1024;
constexpr size_t WS_VC = 47 * MiB;
constexpr size_t WS_GATES = 48 * MiB;
constexpr size_t WS_COS = 54 * MiB, WS_SIN = 58 * MiB;
constexpr size_t WS_H = 64 * MiB;
constexpr size_t WS_T = WS_H;
constexpr size_t WS_QM = 128 * MiB, WS_KM = 160 * MiB, WS_VM = 192 * MiB;
constexpr size_t WS_GZ = 224 * MiB;
constexpr size_t WS_NQROT = 288 * MiB, WS_NQRAW = 320 * MiB;
constexpr size_t WS_KCIN = 352 * MiB, WS_VCIN = 360 * MiB, WS_KS = 368 * MiB, WS_VS = 376 * MiB, WS_KW = 384 * MiB, WS_VW = 392 * MiB;
constexpr size_t WS_ACC = 400 * MiB;
constexpr size_t WS_END = 464 * MiB;

struct Bufs {
    const float* x; const int* pos; const float *w_in, *g_norm, *pe_ck, *pe_cv, *w_ck1, *w_ck2, *w_cv1, *w_cv2, *g_out_moba, *g_out_nsa, *w_out, *g_final;
    float* out; unsigned char* ws;
    __device__ __forceinline__ bf16* b16(size_t off) const { return (bf16*)(ws + off); }
    __device__ __forceinline__ float* f32(size_t off) const { return (float*)(ws + off); }
};

__device__ const float INV_FREQ[64] = {
    1.000000000e+00f, 8.659643531e-01f, 7.498942018e-01f, 6.493816376e-01f, 5.623413324e-01f, 4.869675338e-01f, 4.216965139e-01f, 3.651741147e-01f, 3.162277639e-01f, 2.738419771e-01f, 2.371373922e-01f, 2.053525001e-01f, 1.778279394e-01f, 1.539926529e-01f, 1.333521456e-01f, 1.154782027e-01f,
    1.000000015e-01f, 8.659642935e-02f, 7.498941571e-02f, 6.493816525e-02f, 5.623412877e-02f, 4.869675264e-02f, 4.216964915e-02f, 3.651741147e-02f, 3.162277862e-02f, 2.738419734e-02f, 2.371373586e-02f, 2.053524926e-02f, 1.778279431e-02f, 1.539926510e-02f, 1.333521493e-02f, 1.154781971e-02f,
    9.999999776e-03f, 8.659643121e-03f, 7.498942316e-03f, 6.493816618e-03f, 5.623413250e-03f, 4.869675264e-03f, 4.216964822e-03f, 3.651741426e-03f, 3.162277862e-03f, 2.738419687e-03f, 2.371373819e-03f, 2.053525066e-03f, 1.778279431e-03f, 1.539926627e-03f, 1.333521446e-03f, 1.154781901e-03f,
    1.000000047e-03f, 8.659643354e-04f, 7.498941850e-04f, 6.493816618e-04f, 5.623413017e-04f, 4.869675031e-04f, 4.216965463e-04f, 3.651741135e-04f, 3.162277862e-04f, 2.738419571e-04f, 2.371373848e-04f, 2.053525241e-04f, 1.778279402e-04f, 1.539926452e-04f, 1.333521504e-04f, 1.154782076e-04f};

__device__ __forceinline__ void sincos_acc(float af, float& sn, float& cs) {
    const double a = (double)af;
    const double k = __builtin_rint(a * 0.63661977236758134308);
    const double r = __builtin_fma(-k, 6.123233995736766036e-17, __builtin_fma(-k, 1.57079632679489655800, a));
    const double r2 = r * r;
    double s = -2.5052108385441718775e-8; s = s * r2 + 2.7557319223985890653e-6; s = s * r2 - 1.9841269841269841270e-4; s = s * r2 + 8.3333333333333333333e-3; s = s * r2 - 1.6666666666666666667e-1; s = s * r2 * r + r;
    double c = 2.0876756987868098979e-9; c = c * r2 - 2.7557319223985890653e-7; c = c * r2 + 2.4801587301587301587e-5; c = c * r2 - 1.3888888888888888889e-3; c = c * r2 + 4.1666666666666666667e-2; c = c * r2 - 0.5; c = c * r2 + 1.0;
    const int q = ((int)k) & 3;
    const double ss = (q == 0) ? s : (q == 1) ? c : (q == 2) ? -s : -c;
    const double cc = (q == 0) ? c : (q == 1) ? -s : (q == 2) ? -c : s;
    sn = (float)ss; cs = (float)cc;
}

__host__ __device__ __forceinline__ int tile_kind(int t) {
    if (t < 8) return 0; if (t < 16) return 1; if (t < 20) return 0; if (t == 20 || t == 21) return 1; if (t == 22) return 0; if (t == 23) return 1; if (t == 24) return 0; if (t == 25) return 1; if (t < 30) return 1; return 2;
}
__host__ __device__ __forceinline__ int tile_src_base(int t) { return t < 26 ? t * 256 : (t < 30 ? C_NZ + (t - 26) * 256 : C_NG); }
__host__ __device__ __forceinline__ int win_src_col(int np) {
    const int t = np >> 8, p = np & 255, kind = tile_kind(t), base = tile_src_base(t);
    if (kind == 1) return base + p;
    if (kind == 2) return p < 24 ? base + p : -1;
    const int bj = p >> 7, hl = (p >> 6) & 1, dd = p & 63;
    return base + hl * 128 + bj * 64 + dd;
}

__device__ __forceinline__ void p0_transpose_item(const float* W, int K, int N, bf16* WT, float* scr, int item, int lane, int nblk, int srcmode, const float* gk0, const float* gk1) {
    const int kb = item / nblk, nb = item % nblk, k0 = 64 * kb, n0 = 32 * nb;
    const int np = n0 + (lane & 31);
    const int src = srcmode == 0 ? win_src_col(np) : np;
#pragma unroll 8
    for (int i = 0; i < 32; ++i) { const int kk = 2 * i + (lane >> 5); float v = 0.f;
        if (src >= 0) { v = W[(size_t)(k0 + kk) * N + src]; if (gk0) { const int k = k0 + kk; v *= (k < 1024 ? gk0[k] : gk1[k - 1024]); } }
        scr[kk * 33 + (lane & 31)] = v; }
    asm volatile("s_waitcnt lgkmcnt(0)" ::: "memory");
    const int c = lane & 7;
#pragma unroll
    for (int j = 0; j < 4; ++j) { const int n = (lane >> 3) + 8 * j; const float* s = scr + (8 * c) * 33 + n;
        u32x4 o; o.x = pk2(s[0 * 33], s[1 * 33]); o.y = pk2(s[2 * 33], s[3 * 33]); o.z = pk2(s[4 * 33], s[5 * 33]); o.w = pk2(s[6 * 33], s[7 * 33]);
        *(u32x4*)(WT + (size_t)(n0 + n) * K + k0 + 8 * c) = o; }
    asm volatile("s_waitcnt lgkmcnt(0)" ::: "memory");
}

__device__ __forceinline__ void p0_prologue(const Bufs& Bf, int gw, int NGW, int lane, float* scr) {
    constexpr int I_IN = (2048 / 64) * (NPAD / 32), I_OUT = (2048 / 64) * (2048 / 32), I_C1 = (4096 / 64) * (256 / 32), I_C2 = (256 / 64) * (128 / 32);
    constexpr int NITEMS = I_IN + I_OUT + 2 * I_C1 + 2 * I_C2;
    for (int it = gw; it < NITEMS; it += NGW) {
        int r = it;
        if (r < I_IN) { p0_transpose_item(Bf.w_in, 2048, INC, Bf.b16(WS_WINT), scr, r, lane, NPAD / 32, 0, nullptr, nullptr); continue; } r -= I_IN;
        if (r < I_OUT) { p0_transpose_item(Bf.w_out, 2048, 2048, Bf.b16(WS_WOUTT), scr, r, lane, 2048 / 32, 1, Bf.g_out_moba, Bf.g_out_nsa); continue; } r -= I_OUT;
        if (r < I_C1) { p0_transpose_item(Bf.w_ck1, 4096, 256, Bf.b16(WS_WC1T), scr, r, lane, 256 / 32, 1, nullptr, nullptr); continue; } r -= I_C1;
        if (r < I_C1) { p0_transpose_item(Bf.w_cv1, 4096, 256, Bf.b16(WS_WC1T) + 256 * 4096, scr, r, lane, 256 / 32, 1, nullptr, nullptr); continue; } r -= I_C1;
        if (r < I_C2) { p0_transpose_item(Bf.w_ck2, 256, 128, Bf.b16(WS_WC2T), scr, r, lane, 128 / 32, 1, nullptr, nullptr); continue; } r -= I_C2;
        p0_transpose_item(Bf.w_cv2, 256, 128, Bf.b16(WS_WC2T) + 128 * 256, scr, r, lane, 128 / 32, 1, nullptr, nullptr);
    }
    bf16* H = Bf.b16(WS_H);
    for (int m = gw; m < M; m += NGW) {
        const float* xr = Bf.x + (size_t)m * DM + lane * 8; f32x4 v[8]; float s = 0.f;
#pragma unroll
        for (int j = 0; j < 4; ++j) { v[2 * j] = *(const f32x4*)(xr + j * 512); v[2 * j + 1] = *(const f32x4*)(xr + j * 512 + 4); }
#pragma unroll
        for (int j = 0; j < 8; ++j) s += (v[j].x * v[j].x + v[j].y * v[j].y) + (v[j].z * v[j].z + v[j].w * v[j].w);
        const float rstd = 1.0f / sqrtf(wave_sum(s) * (1.f / DM) + EPS);
#pragma unroll
        for (int j = 0; j < 4; ++j) { const f32x4 g0 = *(const f32x4*)(Bf.g_norm + j * 512 + lane * 8), g1 = *(const f32x4*)(Bf.g_norm + j * 512 + lane * 8 + 4);
            const f32x4 a = v[2 * j] * rstd * g0, b = v[2 * j + 1] * rstd * g1;
            u32x4 o; o.x = pk2(a.x, a.y); o.y = pk2(a.z, a.w); o.z = pk2(b.x, b.y); o.w = pk2(b.z, b.w);
            *(u32x4*)(H + (size_t)m * DM + j * 512 + lane * 8) = o; }
    }
    float* COS = Bf.f32(WS_COS); float* SIN = Bf.f32(WS_SIN);
    for (int i = gw * 64 + lane; i < M * 64; i += NGW * 64) {
        const int row = i >> 6, f = i & 63; const float a = (float)Bf.pos[row] * INV_FREQ[f]; float sn, cs; sincos_acc(a, sn, cs); COS[i] = cs; SIN[i] = sn; }
    float* CB = Bf.f32(WS_CBIAS);
    for (int it = gw; it < 2 * 64; it += NGW) { const int kv = it >> 6, c = it & 63; const float* pe = kv ? Bf.pe_cv : Bf.pe_ck; const float* w1 = kv ? Bf.w_cv1 : Bf.w_ck1;
        float a0 = 0.f, a1 = 0.f, a2 = 0.f, a3 = 0.f;
        for (int k = 64 * c; k < 64 * c + 64; ++k) { const float p = pe[k]; const float* wr = w1 + (size_t)k * 256 + lane; a0 += p * wr[0]; a1 += p * wr[64]; a2 += p * wr[128]; a3 += p * wr[192]; }
        float* o = CB + (size_t)(kv * 64 + c) * 256 + lane; o[0] = a0; o[64] = a1; o[128] = a2; o[192] = a3; }
}


namespace pg8 {
#define PG8_LAS __attribute__((address_space(3)))
typedef unsigned short bf16_t;
typedef short bf16x8 __attribute__((ext_vector_type(8)));
typedef float f32x4 __attribute__((ext_vector_type(4)));
typedef unsigned u32x4 __attribute__((ext_vector_type(4)));
constexpr int BM = 256, BK = 64, HALF = 128, HTB = HALF * BK * 2  , STAGE_BYTES = 8 * HTB, NXCD = 8, WGM = 8;

__host__ __device__ __forceinline__ int lds_byte(int r, int c) { const int st = (r >> 4) * 2 + (c >> 5), rr = r & 15, cc = c & 31, ob = rr * 64 + cc * 2; return st * 1024 + (ob ^ (((ob >> 9) & 1) << 5)); }
__host__ __device__ __forceinline__ void stage_rc(int b, int& R, int& C) { const int st = b / 1024, sb = b % 1024, swz = sb ^ (((sb >> 9) & 1) << 5); R = (st >> 1) * 16 + swz / 64; C = (st & 1) * 32 + (swz % 64) / 2; }
__host__ __device__ __forceinline__ int perm32(int rho) { const int n = rho >> 4, i = rho & 15; return 8 * (i >> 2) + 4 * n + (i & 3); }

struct Unit { int pm, pn; };
struct Gemm { const bf16_t* A; const bf16_t* Bt; int M, N, K; };

struct StaticOrder {
    int nM, nN, nwg, G, c;
    __host__ __device__ void init(int M, int N, int G_, int c_) { nM = M / BM; nN = N / BM; nwg = nM * nN; G = G_; c = c_; }
    __host__ __device__ bool next(int i, Unit& u) const {
        const long L = (long)i * G + c; if (L >= nwg) return false;
        int wgid = (int)L; { const int q = nwg / NXCD, r = nwg % NXCD, xcd = wgid % NXCD, off = wgid / NXCD; wgid = (xcd < r ? xcd * (q + 1) : r * (q + 1) + (xcd - r) * q) + off; }
        const int nig = WGM * nN, gid = wgid / nig, fm = gid * WGM, gsz = (nM - fm) < WGM ? (nM - fm) : WGM;
        u.pm = fm + ((wgid % nig) % gsz); u.pn = (wgid % nig) / gsz; return true;
    }
    __device__ __forceinline__ void a_ready(const Unit&) const {}
    __device__ __forceinline__ void done(const Unit&) const {}
};

__device__ __forceinline__ unsigned cvt_pk_bf16(float lo, float hi) { unsigned r; asm volatile("v_cvt_pk_bf16_f32 %0, %1, %2" : "=v"(r) : "v"(lo), "v"(hi)); return r; }

template <class Epi, class Sched, bool ALIGN_EPI = false, bool SP2 = false>
__device__ __forceinline__ void gemm_phase(PG8_LAS unsigned char* lds, const Gemm g, const Sched& S, const Epi& E) {
    const int tid = threadIdx.x, wid = __builtin_amdgcn_readfirstlane(tid >> 6), lane = tid & 63, wr = wid >> 2, wc = wid & 3, fr = lane & 15, fq = lane >> 4;
    const int K = g.K, nt = K / BK;
    unsigned voffA[2], voffB[2];
#pragma unroll
    for (int i = 0; i < 2; ++i) { int R, C; stage_rc(tid * 16 + i * 8192, R, C); const int Rb = Epi::PERM ? ((R & ~31) + perm32(R & 31)) : R;
        voffA[i] = (unsigned)(R * K + C) * 2u; voffB[i] = (unsigned)(Rb * K + C) * 2u; }
    const size_t kstep = (size_t)(BK * 2);
    const size_t hstep = (size_t)HALF * K * 2;
    const size_t tstep = 2 * hstep;
    const unsigned ldsw = (unsigned)wid * 1024u;
    const int aoff = lds_byte(wr * 64 + fr, fq * 8), boff = lds_byte(wc * 32 + fr, fq * 8);
#define PG8_SA(b, h) (((b) * 2 + (h)) * HTB)
#define PG8_SB(b, h) ((4 + (b) * 2 + (h)) * HTB)
#define PG8_STAGE(bufoff, gbase, voff) do { _Pragma("unroll") for (int _i = 0; _i < 2; ++_i) \
        __builtin_amdgcn_global_load_lds((const unsigned*)((const char*)(gbase) + (voff)[_i]), (PG8_LAS unsigned*)(lds + (bufoff) + ldsw + _i * 8192), 16, 0, 0); } while (0)
#define PG8_LDA(dst, b, h) do { _Pragma("unroll") for (int m = 0; m < 4; ++m) _Pragma("unroll") for (int k = 0; k < 2; ++k) dst[m][k] = *(const PG8_LAS bf16x8*)(lds + PG8_SA(b, h) + aoff + m * 2048 + k * 1024); } while (0)
#define PG8_LDB(dst, b, h) do { _Pragma("unroll") for (int n = 0; n < 2; ++n) _Pragma("unroll") for (int k = 0; k < 2; ++k) dst[n][k] = *(const PG8_LAS bf16x8*)(lds + PG8_SB(b, h) + boff + n * 2048 + k * 1024); } while (0)
#define PG8_MMA(ai, bj, At, Bt) do { __builtin_amdgcn_s_setprio(1); _Pragma("unroll") for (int m = 0; m < 4; ++m) _Pragma("unroll") for (int n = 0; n < 2; ++n) _Pragma("unroll") for (int k = 0; k < 2; ++k) \
        acc[ai][bj][m][n] = __builtin_amdgcn_mfma_f32_16x16x32_bf16(Bt[n][k], At[m][k], acc[ai][bj][m][n], 0, 0, 0); __builtin_amdgcn_s_setprio(0); } while (0)
#define PG8_WAIT_V(n) asm volatile("s_waitcnt vmcnt(" #n ")" ::: "memory")
#define PG8_WAIT_L(n) asm volatile("s_waitcnt lgkmcnt(" #n ")" ::: "memory")
#define PG8_BAR __builtin_amdgcn_s_barrier()
#define PG8_SCHED __builtin_amdgcn_sched_barrier(0)
    Unit cur, nxt; int ui = 0;
    if (!S.next(0, cur)) return;
    f32x4 acc[2][2][4][2];
#pragma unroll
    for (int a = 0; a < 2; ++a)
#pragma unroll
        for (int b = 0; b < 2; ++b)
#pragma unroll
            for (int m = 0; m < 4; ++m)
#pragma unroll
                for (int n = 0; n < 2; ++n) acc[a][b][m][n] = (f32x4){0.f, 0.f, 0.f, 0.f};
    bf16x8 At[4][2], B0[2][2], B1[2][2];
    const char* cA = (const char*)g.A + (size_t)cur.pm * tstep; const char* cB = (const char*)g.Bt + (size_t)cur.pn * tstep;
    S.a_ready(cur);
    if constexpr (SP2) {
        PG8_STAGE(PG8_SB(0, 0), cB, voffB); PG8_STAGE(PG8_SB(0, 1), cB + hstep, voffB); PG8_STAGE(PG8_SA(0, 0), cA, voffA); PG8_STAGE(PG8_SA(0, 1), cA + hstep, voffA);
        if (wr == 1) PG8_BAR;
        PG8_WAIT_V(2); PG8_BAR;
        PG8_STAGE(PG8_SB(1, 0), cB + kstep, voffB); PG8_STAGE(PG8_SA(1, 0), cA + kstep, voffA); PG8_STAGE(PG8_SB(1, 1), cB + hstep + kstep, voffB);
        PG8_WAIT_V(6); PG8_BAR;
    } else {
        PG8_STAGE(PG8_SB(0, 0), cB, voffB); PG8_STAGE(PG8_SA(0, 0), cA, voffA); PG8_STAGE(PG8_SB(0, 1), cB + hstep, voffB); PG8_STAGE(PG8_SA(0, 1), cA + hstep, voffA);
        if (wr == 1) PG8_BAR;
        PG8_WAIT_V(4); PG8_BAR;
        PG8_STAGE(PG8_SB(1, 0), cB + kstep, voffB); PG8_STAGE(PG8_SA(1, 0), cA + kstep, voffA); PG8_STAGE(PG8_SB(1, 1), cB + hstep + kstep, voffB);
        PG8_WAIT_V(6); PG8_BAR;
    }
    for (;;) {
        const bool has_next = S.next(ui + 1, nxt);
        const char* nA = has_next ? (const char*)g.A + (size_t)nxt.pm * tstep : cA; const char* nB = has_next ? (const char*)g.Bt + (size_t)nxt.pn * tstep : cB;
        for (int t = 0; t < nt; t += 2) {
            const bool last = (t == nt - 2);
            const char* a1 = cA + (size_t)(t + 1) * kstep;
            const char* a2 = last ? nA : cA + (size_t)(t + 2) * kstep; const char* b2 = last ? nB : cB + (size_t)(t + 2) * kstep;
            const char* a3 = a2 + kstep; const char* b3 = b2 + kstep;
            if (last && has_next) S.a_ready(nxt);
            if constexpr (SP2) {
            PG8_LDB(B0, 0, 0); PG8_LDB(B1, 0, 1); PG8_SCHED; PG8_LDA(At, 0, 0); PG8_STAGE(PG8_SA(1, 1), a1 + hstep, voffA);
            PG8_WAIT_V(8); PG8_WAIT_L(0); PG8_BAR; PG8_MMA(0, 0, At, B0); PG8_MMA(0, 1, At, B1); PG8_BAR; PG8_SCHED;
            PG8_LDA(At, 0, 1); PG8_STAGE(PG8_SB(0, 0), b2, voffB); PG8_STAGE(PG8_SB(0, 1), b2 + hstep, voffB); PG8_STAGE(PG8_SA(0, 0), a2, voffA);
            PG8_WAIT_V(8); PG8_WAIT_L(0); PG8_BAR; PG8_MMA(1, 0, At, B0); PG8_MMA(1, 1, At, B1); PG8_BAR; PG8_SCHED;
            PG8_LDB(B0, 1, 0); PG8_LDB(B1, 1, 1); PG8_SCHED; PG8_LDA(At, 1, 0); PG8_STAGE(PG8_SA(0, 1), a2 + hstep, voffA);
            PG8_WAIT_V(8); PG8_WAIT_L(0); PG8_BAR; PG8_MMA(0, 0, At, B0); PG8_MMA(0, 1, At, B1); PG8_BAR; PG8_SCHED;
            PG8_LDA(At, 1, 1); PG8_STAGE(PG8_SB(1, 0), b3, voffB); PG8_STAGE(PG8_SB(1, 1), b3 + hstep, voffB); PG8_STAGE(PG8_SA(1, 0), a3, voffA);
            PG8_WAIT_V(8); PG8_WAIT_L(0); PG8_BAR; PG8_MMA(1, 0, At, B0); PG8_MMA(1, 1, At, B1); PG8_BAR; PG8_SCHED;
            } else {
            PG8_LDB(B0, 0, 0); PG8_SCHED; PG8_LDA(At, 0, 0); PG8_STAGE(PG8_SA(1, 1), a1 + hstep, voffA);
            PG8_WAIT_L(8); PG8_BAR; PG8_WAIT_L(0); PG8_MMA(0, 0, At, B0); PG8_BAR; PG8_SCHED;
            PG8_LDB(B1, 0, 1); PG8_STAGE(PG8_SB(0, 0), b2, voffB);
            PG8_BAR; PG8_WAIT_L(0); PG8_MMA(0, 1, At, B1); PG8_BAR;
            PG8_LDA(At, 0, 1); PG8_STAGE(PG8_SA(0, 0), a2, voffA);
            PG8_BAR; PG8_WAIT_L(0); PG8_MMA(1, 0, At, B0); PG8_BAR; PG8_SCHED;
            PG8_STAGE(PG8_SB(0, 1), b2 + hstep, voffB);
            PG8_WAIT_V(6); PG8_BAR; PG8_MMA(1, 1, At, B1); PG8_BAR;
            PG8_LDB(B0, 1, 0); PG8_SCHED; PG8_LDA(At, 1, 0); PG8_STAGE(PG8_SA(0, 1), a2 + hstep, voffA);
            PG8_WAIT_L(8); PG8_BAR; PG8_WAIT_L(0); PG8_MMA(0, 0, At, B0); PG8_BAR; PG8_SCHED;
            PG8_LDB(B1, 1, 1); PG8_STAGE(PG8_SB(1, 0), b3, voffB);
            PG8_BAR; PG8_WAIT_L(0); PG8_MMA(0, 1, At, B1); PG8_BAR;
            PG8_LDA(At, 1, 1); PG8_STAGE(PG8_SA(1, 0), a3, voffA);
            PG8_BAR; PG8_WAIT_L(0); PG8_MMA(1, 0, At, B0); PG8_BAR; PG8_SCHED;
            PG8_STAGE(PG8_SB(1, 1), b3 + hstep, voffB);
            PG8_WAIT_V(6); PG8_BAR; PG8_MMA(1, 1, At, B1); PG8_BAR;
            }
        }
        if constexpr (ALIGN_EPI) { if (wr == 0) PG8_BAR; }
        if constexpr (!Epi::AFTER_DRAIN) { E(acc, cur, wr, wc, fr, fq); S.done(cur); }
        if (!has_next) break;
#pragma unroll
        for (int a = 0; a < 2; ++a)
#pragma unroll
            for (int b = 0; b < 2; ++b)
#pragma unroll
                for (int m = 0; m < 4; ++m)
#pragma unroll
                    for (int n = 0; n < 2; ++n) acc[a][b][m][n] = (f32x4){0.f, 0.f, 0.f, 0.f};
        cur = nxt; cA = nA; cB = nB; ++ui;
        if constexpr (ALIGN_EPI) { if (wr == 1) PG8_BAR; }
    }
    PG8_WAIT_V(0);
    if constexpr (!ALIGN_EPI) { if (wr == 0) PG8_BAR; }
    PG8_BAR;
    if constexpr (Epi::AFTER_DRAIN) { E.fused(acc, cur, wr, wc, fr, fq, lds, wid, lane); S.done(cur); }
#undef PG8_SA
#undef PG8_SB
#undef PG8_STAGE
#undef PG8_LDA
#undef PG8_LDB
#undef PG8_MMA
#undef PG8_WAIT_V
#undef PG8_WAIT_L
#undef PG8_BAR
#undef PG8_SCHED
}
}

struct EpiIn {
    static constexpr bool PERM = true, AFTER_DRAIN = false;
    Bufs bf;
    __device__ __forceinline__ void operator()(const f32x4 (&acc)[2][2][4][2], const pg8::Unit& u, int wr, int wc, int fr, int fq) const {
        const int t = u.pn, kind = tile_kind(t);
        const int b = u.pm >> 3, s0 = (u.pm & 7) * 256 + wr * 64 + fr, row0 = u.pm * 256 + wr * 64 + fr;
        if (kind == 0) {
            bf16* dst; bf16* raw = nullptr; int nh = 8, hb = 0;
            if (t < 4) { dst = bf.b16(WS_QM); hb = 2 * t; } else if (t < 8) { dst = bf.b16(WS_KM); hb = 2 * (t - 4); }
            else if (t < 20) { dst = bf.b16(WS_NQROT); raw = bf.b16(WS_NQRAW); hb = 2 * (t - 16); } else if (t == 22) { dst = bf.b16(WS_KS); nh = 2; } else { dst = bf.b16(WS_KW); nh = 2; }
            const int head = hb + (wc >> 1), dd0 = 32 * (wc & 1) + 8 * fq;
            const bool km = (t >= 4 && t < 8);
            const float* COS = bf.f32(WS_COS); const float* SIN = bf.f32(WS_SIN);
            f32x4 k1a = {0.f, 0.f, 0.f, 0.f}, k1b = k1a, k2a = k1a, k2b = k1a;
#pragma unroll
            for (int ai = 0; ai < 2; ++ai)
#pragma unroll
                for (int m = 0; m < 4; ++m) {
                    const int s = s0 + 128 * ai + 16 * m, row = row0 + 128 * ai + 16 * m;
                    const f32x4 c0 = *(const f32x4*)(COS + (size_t)row * 64 + dd0), c1 = *(const f32x4*)(COS + (size_t)row * 64 + dd0 + 4);
                    const f32x4 n0 = *(const f32x4*)(SIN + (size_t)row * 64 + dd0), n1 = *(const f32x4*)(SIN + (size_t)row * 64 + dd0 + 4);
                    const f32x4 x1a = acc[ai][0][m][0], x1b = acc[ai][0][m][1], x2a = acc[ai][1][m][0], x2b = acc[ai][1][m][1];
                    const f32x4 o1a = x1a * c0 - x2a * n0, o1b = x1b * c1 - x2b * n1, o2a = x2a * c0 + x1a * n0, o2b = x2b * c1 + x1b * n1;
                    const size_t o = ((size_t)(b * nh + head) * SEQ + s) * HD + dd0;
                    u32x4 w; w.x = pg8::cvt_pk_bf16(o1a[0], o1a[1]); w.y = pg8::cvt_pk_bf16(o1a[2], o1a[3]); w.z = pg8::cvt_pk_bf16(o1b[0], o1b[1]); w.w = pg8::cvt_pk_bf16(o1b[2], o1b[3]);
                    *(u32x4*)(dst + o) = w;
                    w.x = pg8::cvt_pk_bf16(o2a[0], o2a[1]); w.y = pg8::cvt_pk_bf16(o2a[2], o2a[3]); w.z = pg8::cvt_pk_bf16(o2b[0], o2b[1]); w.w = pg8::cvt_pk_bf16(o2b[2], o2b[3]);
                    *(u32x4*)(dst + o + 64) = w;
                    if (raw) {
                        w.x = pg8::cvt_pk_bf16(x1a[0], x1a[1]); w.y = pg8::cvt_pk_bf16(x1a[2], x1a[3]); w.z = pg8::cvt_pk_bf16(x1b[0], x1b[1]); w.w = pg8::cvt_pk_bf16(x1b[2], x1b[3]);
                        *(u32x4*)(raw + o) = w;
                        w.x = pg8::cvt_pk_bf16(x2a[0], x2a[1]); w.y = pg8::cvt_pk_bf16(x2a[2], x2a[3]); w.z = pg8::cvt_pk_bf16(x2b[0], x2b[1]); w.w = pg8::cvt_pk_bf16(x2b[2], x2b[3]);
                        *(u32x4*)(raw + o + 64) = w;
                    }
                    if (km) { k1a += o1a; k1b += o1b; k2a += o2a; k2b += o2b; }
                }
            if (km) {
#pragma unroll
                for (int off = 1; off < 16; off <<= 1)
#pragma unroll
                    for (int j = 0; j < 4; ++j) { k1a[j] += __shfl_xor(k1a[j], off); k1b[j] += __shfl_xor(k1b[j], off); k2a[j] += __shfl_xor(k2a[j], off); k2b[j] += __shfl_xor(k2b[j], off); }
                if (fr == 0) { float* kp = bf.f32(WS_KMS) + ((size_t)(b * 8 + head) * 8 + (u.pm & 7)) * 128 + dd0;
#pragma unroll
                    for (int j = 0; j < 4; ++j) { atomicAdd(kp + j, k1a[j]); atomicAdd(kp + 4 + j, k1b[j]); atomicAdd(kp + 64 + j, k2a[j]); atomicAdd(kp + 68 + j, k2b[j]); } }
            }
        } else if (kind == 1) {
            const bool isz = (t >= 12 && t < 16) || t >= 26;
            if (isz) {
                bf16* gz = bf.b16(WS_GZ) + (t < 16 ? (t - 12) * 256 : 1024 + (t - 26) * 256) + 32 * wc + 8 * fq;
#pragma unroll
                for (int ai = 0; ai < 2; ++ai)
#pragma unroll
                    for (int m = 0; m < 4; ++m) { const int row = row0 + 128 * ai + 16 * m;
#pragma unroll
                        for (int bj = 0; bj < 2; ++bj) { const f32x4 a = acc[ai][bj][m][0], c = acc[ai][bj][m][1];
                            u32x4 w; w.x = pg8::cvt_pk_bf16(silu_f(a[0]), silu_f(a[1])); w.y = pg8::cvt_pk_bf16(silu_f(a[2]), silu_f(a[3])); w.z = pg8::cvt_pk_bf16(silu_f(c[0]), silu_f(c[1])); w.w = pg8::cvt_pk_bf16(silu_f(c[2]), silu_f(c[3]));
                            *(u32x4*)(gz + (size_t)row * 2048 + 128 * bj) = w; } }
            } else {
                bf16* dst; int nh = 2, hb = 0;
                if (t < 12) { dst = bf.b16(WS_VM); nh = 8; hb = 2 * (t - 8); } else if (t == 20) dst = bf.b16(WS_KCIN); else if (t == 21) dst = bf.b16(WS_VCIN); else if (t == 23) dst = bf.b16(WS_VS); else dst = bf.b16(WS_VW);
#pragma unroll
                for (int ai = 0; ai < 2; ++ai)
#pragma unroll
                    for (int m = 0; m < 4; ++m) { const int s = s0 + 128 * ai + 16 * m;
#pragma unroll
                        for (int bj = 0; bj < 2; ++bj) { const f32x4 a = acc[ai][bj][m][0], c = acc[ai][bj][m][1];
                            u32x4 w; w.x = pg8::cvt_pk_bf16(a[0], a[1]); w.y = pg8::cvt_pk_bf16(a[2], a[3]); w.z = pg8::cvt_pk_bf16(c[0], c[1]); w.w = pg8::cvt_pk_bf16(c[2], c[3]);
                            *(u32x4*)(dst + ((size_t)(b * nh + hb + bj) * SEQ + s) * HD + 32 * wc + 8 * fq) = w; } }
            }
        } else {
            if (wc == 0 && fq < 3) { float* gp = bf.f32(WS_GATES) + 8 * fq;
#pragma unroll
                for (int ai = 0; ai < 2; ++ai)
#pragma unroll
                    for (int m = 0; m < 4; ++m) { const int row = row0 + 128 * ai + 16 * m; const f32x4 a = acc[ai][0][m][0], c = acc[ai][0][m][1];
                        *(f32x4*)(gp + (size_t)row * 24) = (f32x4){sigmoid_f(a[0]), sigmoid_f(a[1]), sigmoid_f(a[2]), sigmoid_f(a[3])};
                        *(f32x4*)(gp + (size_t)row * 24 + 4) = (f32x4){sigmoid_f(c[0]), sigmoid_f(c[1]), sigmoid_f(c[2]), sigmoid_f(c[3])}; } }
        }
    }
};
struct EpiOut {
    static constexpr bool PERM = false, AFTER_DRAIN = false;
    const float* x; float* out;
    __device__ __forceinline__ void operator()(const f32x4 (&acc)[2][2][4][2], const pg8::Unit& u, int wr, int wc, int fr, int fq) const {
        const int row0 = u.pm * 256 + wr * 64 + fr, col0 = u.pn * 256 + wc * 32 + 4 * fq;
#pragma unroll
        for (int ai = 0; ai < 2; ++ai)
#pragma unroll
            for (int m = 0; m < 4; ++m) { const size_t off = (size_t)(row0 + 128 * ai + 16 * m) * DM + col0;
#pragma unroll
                for (int bj = 0; bj < 2; ++bj)
#pragma unroll
                    for (int n = 0; n < 2; ++n) { const size_t o = off + bj * 128 + n * 16; *(f32x4*)(out + o) = *(const f32x4*)(x + o) + acc[ai][bj][m][n]; } }
    }
};

namespace att {
constexpr int SHM_K = 16384, SHM_V = 16384;
constexpr int L_V = 0, L_K = 32768, L_WS = 65536, L_SEL = 67584, L_ITEM = 67840, L_IMP = 68096, L_SCORE = L_IMP + 32768, L_ACC = L_IMP;
constexpr float THR = 8.f;
constexpr float C2 = 1.4426950408889634f * SCALE;
constexpr unsigned WBIG = 0x7fffffffu;
#define KSWZ(row, colB) ((row) * 256 + ((colB) ^ (((row) & 7) << 4)))
#define SBAR() __builtin_amdgcn_sched_barrier(0)
__device__ __forceinline__ int v_st(int k, int c) { const int kk = (k & ~0xC) | ((k & 4) << 1) | ((k & 8) >> 1); return ((kk >> 3) * 4 + (c >> 5)) * 512 + ((kk & 7) * 32 + (c & 31)) * 2; }
__device__ __forceinline__ int v_rd_base(int lane) { return ((lane & 3) << 3) | (((lane >> 2) & 3) << 6) | (((lane >> 4) & 1) << 5) | (((lane >> 5) & 1) << 8); }
constexpr int v_rd_off(int d0, int ks, int half) { return d0 * 512 + ks * 4096 + half * 2048; }
__device__ __forceinline__ int crow(int r, int hi) { return (r & 3) + 8 * (r >> 2) + 4 * hi; }
__device__ __forceinline__ unsigned cvtpk(float lo, float hi) { unsigned r; asm volatile("v_cvt_pk_bf16_f32 %0, %1, %2" : "=v"(r) : "v"(lo), "v"(hi)); return r; }
typedef short s16x4 __attribute__((ext_vector_type(4)));
__device__ __forceinline__ int opaque_tid() { int t = threadIdx.x; asm volatile("" : "+v"(t)); return t; }

__device__ __forceinline__ void mask_tile(f32x16& p0, f32x16& p1, int dq, unsigned W) {
    const float NEG = -__builtin_inff();
#pragma unroll
    for (int r = 0; r < 16; ++r) { const int c = (r & 3) + 8 * (r >> 2);
        if ((unsigned)(dq - c) >= W) p0[r] = NEG;
        if ((unsigned)(dq - c - 32) >= W) p1[r] = NEG; }
}
#define PK4(P, B_, OUT) do { unsigned a0 = cvtpk(P[B_+0], P[B_+1]), a1 = cvtpk(P[B_+2], P[B_+3]); unsigned b0 = cvtpk(P[B_+4], P[B_+5]), b1 = cvtpk(P[B_+6], P[B_+7]); \
        auto r0 = __builtin_amdgcn_permlane32_swap(a0, b0, false, false); auto r1 = __builtin_amdgcn_permlane32_swap(a1, b1, false, false); \
        u32x4 w = {r0[0], r1[0], r0[1], r1[1]}; OUT = *reinterpret_cast<bf16x8*>(&w); } while (0)
__device__ __forceinline__ float softmax_tile(f32x16& p0, f32x16& p1, float& m_reg, float& l_reg, bool rowok, bf16x8& pa0, bf16x8& pa1, bf16x8& pa2, bf16x8& pa3) {
    float pmax = p0[0];
#pragma unroll
    for (int r = 1; r < 16; ++r) pmax = fmaxf(pmax, p0[r]);
#pragma unroll
    for (int r = 0; r < 16; ++r) pmax = fmaxf(pmax, p1[r]);
    { auto rr = __builtin_amdgcn_permlane32_swap(__float_as_uint(pmax), __float_as_uint(pmax), false, false); pmax = fmaxf(__uint_as_float(rr[0]), __uint_as_float(rr[1])); }
    if (!rowok) pmax = -__builtin_inff();
    float mn, alpha;
    if (__builtin_expect(__all((pmax - m_reg) * SCALE <= THR), 1)) { mn = m_reg; alpha = 1.f; }
    else { mn = fmaxf(m_reg, pmax); alpha = __builtin_amdgcn_exp2f((m_reg - mn) * C2); m_reg = mn; }
    const float mnL = rowok ? -mn * C2 : -__builtin_inff();
#pragma unroll
    for (int r = 0; r < 16; ++r) { p0[r] = __builtin_amdgcn_exp2f(fmaf(p0[r], C2, mnL)); p1[r] = __builtin_amdgcn_exp2f(fmaf(p1[r], C2, mnL)); }
    float ps = 0.f;
#pragma unroll
    for (int r = 0; r < 16; ++r) ps += p0[r];
#pragma unroll
    for (int r = 0; r < 16; ++r) ps += p1[r];
    { auto rr = __builtin_amdgcn_permlane32_swap(__float_as_uint(ps), __float_as_uint(ps), false, false); ps = __uint_as_float(rr[0]) + __uint_as_float(rr[1]); }
    l_reg = l_reg * alpha + ps;
    PK4(p0, 0, pa0); PK4(p0, 8, pa1); PK4(p1, 0, pa2); PK4(p1, 8, pa3);
    return alpha;
}
__device__ __forceinline__ void qkt(f32x16& p0, f32x16& p1, const char* Kb, int r32, int hi, const bf16x8 (&qr)[8]) {
    p0 = f32x16{}; p1 = f32x16{};
    const char* kb[4];
#pragma unroll
    for (int dd = 0; dd < 4; ++dd) kb[dd] = Kb + KSWZ(r32, (dd * 16 + hi * 8) * 2);
#pragma unroll
    for (int d0 = 0; d0 < 8; ++d0) { const char* a = kb[d0 & 3] + (d0 >> 2) * 128;
        const bf16x8 b0 = *reinterpret_cast<const bf16x8*>(a);
        const bf16x8 b1 = *reinterpret_cast<const bf16x8*>(a + 32 * 256);
        p0 = __builtin_amdgcn_mfma_f32_32x32x16_bf16(b0, qr[d0], p0, 0, 0, 0);
        p1 = __builtin_amdgcn_mfma_f32_32x32x16_bf16(b1, qr[d0], p1, 0, 0, 0); }
}
__device__ __forceinline__ void qkt_half(f32x16& p0, const char* Kb, int r32, int hi, const bf16x8 (&qr)[8]) {
    p0 = f32x16{};
    const char* kb[4];
#pragma unroll
    for (int dd = 0; dd < 4; ++dd) kb[dd] = Kb + KSWZ(r32, (dd * 16 + hi * 8) * 2);
#pragma unroll
    for (int d0 = 0; d0 < 8; ++d0) { const char* a = kb[d0 & 3] + (d0 >> 2) * 128;
        const bf16x8 b0 = *reinterpret_cast<const bf16x8*>(a);
        p0 = __builtin_amdgcn_mfma_f32_32x32x16_bf16(b0, qr[d0], p0, 0, 0, 0); }
}
__device__ __forceinline__ void pv_tile(f32x16 (&o)[4], int vb0, bf16x8 pa0, bf16x8 pa1, bf16x8 pa2, bf16x8 pa3) {
#define TRRD(dst, off) asm volatile("ds_read_b64_tr_b16 %0, %1 offset:%2" : "=&v"(dst) : "v"(vb0), "i"(off) : "memory")
#define PV_D0(d0) do { s16x4 l0, l1, l2, l3, h0, h1, h2, h3; constexpr int b_ = v_rd_off(d0, 0, 0); \
        TRRD(l0, b_); TRRD(h0, b_ + 2048); TRRD(l1, b_ + 4096); TRRD(h1, b_ + 6144); TRRD(l2, b_ + 8192); TRRD(h2, b_ + 10240); TRRD(l3, b_ + 12288); TRRD(h3, b_ + 14336); \
        asm volatile("s_waitcnt lgkmcnt(0)" ::: "memory"); SBAR(); \
        o[d0] = __builtin_amdgcn_mfma_f32_32x32x16_bf16(pa0, (bf16x8){l0[0], l0[1], l0[2], l0[3], h0[0], h0[1], h0[2], h0[3]}, o[d0], 0, 0, 0); \
        o[d0] = __builtin_amdgcn_mfma_f32_32x32x16_bf16(pa1, (bf16x8){l1[0], l1[1], l1[2], l1[3], h1[0], h1[1], h1[2], h1[3]}, o[d0], 0, 0, 0); \
        o[d0] = __builtin_amdgcn_mfma_f32_32x32x16_bf16(pa2, (bf16x8){l2[0], l2[1], l2[2], l2[3], h2[0], h2[1], h2[2], h2[3]}, o[d0], 0, 0, 0); \
        o[d0] = __builtin_amdgcn_mfma_f32_32x32x16_bf16(pa3, (bf16x8){l3[0], l3[1], l3[2], l3[3], h3[0], h3[1], h3[2], h3[3]}, o[d0], 0, 0, 0); } while (0)
    PV_D0(0); PV_D0(1); PV_D0(2); PV_D0(3);
#undef PV_D0
#undef TRRD
}
struct Stage { bf16x8 k0, k1, v0, v1; };
__device__ __forceinline__ void stage_load(Stage& S, const bf16* K, const bf16* V, int krow, int sr, int sc) {
    S.v0 = *(const bf16x8*)(V + (size_t)(krow + sr) * HD + sc); S.v1 = *(const bf16x8*)(V + (size_t)(krow + 32 + sr) * HD + sc);
    S.k0 = *(const bf16x8*)(K + (size_t)(krow + sr) * HD + sc); S.k1 = *(const bf16x8*)(K + (size_t)(krow + 32 + sr) * HD + sc);
}
__device__ __forceinline__ void stage_write(const Stage& S, char* Kb, char* Vb, int kws, int vst0, int vst1) {
    *(bf16x8*)(Kb + kws) = S.k0; *(bf16x8*)(Kb + kws + 32 * 256) = S.k1; *(bf16x8*)(Vb + vst0) = S.v0; *(bf16x8*)(Vb + vst1) = S.v1;
}
#define RESC(a) do { if (__any((a) < 1.f)) { if (hi == 0) al_l[r32] = (a); asm volatile("s_waitcnt lgkmcnt(0)" ::: "memory"); \
        _Pragma("unroll") for (int d_ = 0; d_ < 4; ++d_) _Pragma("unroll") for (int r = 0; r < 16; ++r) o[d_][r] *= al_l[crow(r, hi)]; } } while (0)

template <int MODE>
__device__ __forceinline__ void attn_pass(char* lds, const bf16x8 (&qr)[8], const bf16* K, const bf16* V, int t_lo, int t_hi, int posq, int qlo, unsigned sel, int own, f32x16 (&o)[4], float& l_out) {
    const int tid = opaque_tid(), lane = tid & 63, r32 = lane & 31, hi = lane >> 5, wid = __builtin_amdgcn_readfirstlane(tid >> 6);
    char* V_lds = lds + L_V; char* K_lds = lds + L_K;
    float* al_l = (float*)(lds + L_WS) + wid * 64 + 32;
    const int sr = tid >> 4, sc = (tid & 15) * 8, vst0 = v_st(sr, sc), vst1 = v_st(32 + sr, sc), kws = KSWZ(sr, sc * 2);
    const int vbase = (int)(uintptr_t)V_lds + v_rd_base(lane);
    float m_reg = -1e30f, l_reg = 0.f;
#pragma unroll
    for (int d = 0; d < 4; ++d) o[d] = f32x16{};
    Stage S;
    stage_load(S, K, V, t_lo * 64, sr, sc);
    stage_write(S, K_lds, V_lds, kws, vst0, vst1);
    __syncthreads();
    const int NT = t_hi - t_lo;
    for (int i = 0; i < NT; ++i) {
        const int t = t_lo + i, cur = i & 1, kb = t * 64;
        if (i + 1 < NT) stage_load(S, K, V, kb + 64, sr, sc);
        bool rowok = true, elem = false, act = true; unsigned W = WBIG;
        if (MODE == 0) { const int j = t >> 2; if (j < own) { rowok = (sel >> j) & 1u; act = __any(rowok); } else { elem = kb + 63 > qlo; act = kb <= qlo + 31; } }
        if (MODE == 2) { if (t < own) { rowok = (sel >> t) & 1u; act = __any(rowok); } else elem = true; }
        if (MODE == 3) { W = 512u; elem = (t == own) || (t == own - 8); }
        if (act) {
            f32x16 p0, p1;
            qkt(p0, p1, K_lds + cur * SHM_K, r32, hi, qr);
            if (elem) mask_tile(p0, p1, posq - kb - 4 * hi, W);
            bf16x8 pa0, pa1, pa2, pa3;
            const float alpha = softmax_tile(p0, p1, m_reg, l_reg, rowok, pa0, pa1, pa2, pa3);
            RESC(alpha);
            pv_tile(o, vbase + cur * SHM_V, pa0, pa1, pa2, pa3);
        }
        if (i + 1 < NT) stage_write(S, K_lds + (cur ^ 1) * SHM_K, V_lds + (cur ^ 1) * SHM_V, kws, vst0, vst1);
        __syncthreads();
    }
    l_out = l_reg;
}
#define ROW_RLI(lval) do { if (hi == 0) li_l[r32] = (lval); asm volatile("s_waitcnt lgkmcnt(0)" ::: "memory"); \
        _Pragma("unroll") for (int r = 0; r < 16; ++r) { const float lv_ = li_l[crow(r, hi)]; rli[r] = lv_ > 0.f ? __builtin_amdgcn_rcpf(lv_) : 0.f; } asm volatile("s_waitcnt lgkmcnt(0)" ::: "memory"); } while (0)

__device__ __forceinline__ void moba_item(const Bufs& bf, char* lds, int bh, int own) {
    const int tid = opaque_tid(), lane = tid & 63, r32 = lane & 31, hi = lane >> 5, wid = __builtin_amdgcn_readfirstlane(tid >> 6);
    const int b = bh >> 3, h = bh & 7, qlo = own * 256 + wid * 32, posq = qlo + r32;
    float* li_l = (float*)(lds + L_WS) + wid * 64;
    const bf16* Q = bf.b16(WS_QM) + ((size_t)bh * SEQ + posq) * HD; const bf16* K = bf.b16(WS_KM) + (size_t)bh * SEQ * HD; const bf16* V = bf.b16(WS_VM) + (size_t)bh * SEQ * HD;
    bf16x8 qr[8];
#pragma unroll
    for (int d0 = 0; d0 < 8; ++d0) qr[d0] = *(const bf16x8*)(Q + d0 * 16 + hi * 8);
    unsigned sel = 0u;
    if (own > 0) {
        char* K_lds = lds + L_K;
        if (tid < 256) {
            const int row = tid >> 4, c8 = (tid & 15) * 8; const float* src = bf.f32(WS_KMS) + ((size_t)bh * 8 + (row & 7)) * 128 + c8;
            const f32x4 a = *(const f32x4*)src, c = *(const f32x4*)(src + 4); float v[8] = {a[0], a[1], a[2], a[3], c[0], c[1], c[2], c[3]};
            if (row >= 8) {
#pragma unroll
                for (int j = 0; j < 8; ++j) v[j] = v[j] - bf2f(f2bf(v[j])); }
            u32x4 w; w.x = pk2(v[0], v[1]); w.y = pk2(v[2], v[3]); w.z = pk2(v[4], v[5]); w.w = pk2(v[6], v[7]);
            *(u32x4*)(K_lds + KSWZ(row, c8 * 2)) = w;
        }
        __syncthreads();
        f32x16 gp; qkt_half(gp, K_lds, r32, hi, qr);
        float gm[4], go[4], g[8];
#pragma unroll
        for (int j = 0; j < 4; ++j) gm[j] = gp[j] + gp[4 + j];
#pragma unroll
        for (int j = 0; j < 4; ++j) go[j] = __shfl_xor(gm[j], 32);
#pragma unroll
        for (int j = 0; j < 4; ++j) { g[j] = hi ? go[j] : gm[j]; g[4 + j] = hi ? gm[j] : go[j]; }
#pragma unroll
        for (int j = 0; j < 8; ++j) { int rank = 0;
#pragma unroll
            for (int k = 0; k < 8; ++k) if (k != j) rank += (k < own && (g[k] > g[j] || (g[k] == g[j] && k < j))) ? 1 : 0;
            if (j < own && rank < 3) sel |= 1u << j; }
        __syncthreads();
    }
    f32x16 o[4]; float l;
    attn_pass<0>(lds, qr, K, V, 0, 4 * own + 4, posq, qlo, sel, own, o, l);
    float rli[16]; ROW_RLI(l);
    const size_t tok0 = (size_t)b * SEQ + own * 256 + wid * 32;
    const bf16* GZ = bf.b16(WS_GZ); bf16* T = bf.b16(WS_T);
#pragma unroll
    for (int r = 0; r < 16; ++r) { const size_t base = (tok0 + crow(r, hi)) * 2048 + h * 128 + r32;
#pragma unroll
        for (int d0 = 0; d0 < 4; ++d0) { const float v = o[d0][r] * rli[r]; const float vn = __shfl_xor(v, 1);
            if ((r32 & 1) == 0) { const unsigned gz = *(const unsigned*)(GZ + base + d0 * 32); *(unsigned*)(T + base + d0 * 32) = cvtpk(v * bf2f(gz & 0xffffu), vn * bf2f(gz >> 16)); } } }
}

__device__ __forceinline__ void nsa_item(const Bufs& bf, char* lds, int bg, int own) {
    const int tid = opaque_tid(), lane = tid & 63, r32 = lane & 31, hi = lane >> 5, wid = __builtin_amdgcn_readfirstlane(tid >> 6);
    const int b = bg >> 1, g = bg & 1, headr = wid >> 1, head = 4 * g + headr, qq = 32 * (wid & 1) + r32, qlo = 64 * own + 32 * (wid & 1), posq = qlo + r32;
    char* V_lds = lds + L_V; char* K_lds = lds + L_K;
    float* li_l = (float*)(lds + L_WS) + wid * 64;
    float* impb = (float*)(lds + L_IMP); float* scoreb = (float*)(lds + L_SCORE); unsigned* selb = (unsigned*)(lds + L_SEL);
    const int sr = tid >> 4, sc = (tid & 15) * 8, vst0 = v_st(sr, sc), vst1 = v_st(32 + sr, sc), kws = KSWZ(sr, sc * 2);
    const int vbase = (int)(uintptr_t)V_lds + v_rd_base(lane);
    const size_t tok0 = (size_t)b * SEQ + qlo;
    const float* GT = bf.f32(WS_GATES) + (g * 4 + headr) * 3;
    bf16x8 qr[8]; f32x16 o[4]; float rli[16];
    {
        const bf16* KC = bf.b16(WS_KC) + (size_t)bg * 128 * HD; const bf16* VC = bf.b16(WS_VC) + (size_t)bg * 128 * HD;
        const bf16* Q = bf.b16(WS_NQRAW) + ((size_t)(b * 8 + head) * SEQ + posq) * HD;
#pragma unroll
        for (int d0 = 0; d0 < 8; ++d0) qr[d0] = *(const bf16x8*)(Q + d0 * 16 + hi * 8);
        { Stage S0, S1; stage_load(S0, KC, VC, 0, sr, sc); stage_load(S1, KC, VC, 64, sr, sc);
          stage_write(S0, K_lds, V_lds, kws, vst0, vst1); stage_write(S1, K_lds + SHM_K, V_lds + SHM_V, kws, vst0, vst1); }
        __syncthreads();
        f32x16 pA0, pA1, pB0, pB1;
        qkt(pA0, pA1, K_lds, r32, hi, qr); qkt(pB0, pB1, K_lds + SHM_K, r32, hi, qr);
        const int nmax = (posq - 31) >> 4;
        mask_tile(pA0, pA1, nmax - 4 * hi, WBIG); mask_tile(pB0, pB1, nmax - 64 - 4 * hi, WBIG);
        float pmax = pA0[0];
#pragma unroll
        for (int r = 0; r < 16; ++r) pmax = fmaxf(fmaxf(pmax, pA0[r]), fmaxf(pA1[r], fmaxf(pB0[r], pB1[r])));
        { auto rr = __builtin_amdgcn_permlane32_swap(__float_as_uint(pmax), __float_as_uint(pmax), false, false); pmax = fmaxf(__uint_as_float(rr[0]), __uint_as_float(rr[1])); }
        const float mnL = (pmax == -__builtin_inff()) ? 0.f : -pmax * C2;
        float ps = 0.f;
#pragma unroll
        for (int r = 0; r < 16; ++r) { pA0[r] = __builtin_amdgcn_exp2f(fmaf(pA0[r], C2, mnL)); pA1[r] = __builtin_amdgcn_exp2f(fmaf(pA1[r], C2, mnL));
            pB0[r] = __builtin_amdgcn_exp2f(fmaf(pB0[r], C2, mnL)); pB1[r] = __builtin_amdgcn_exp2f(fmaf(pB1[r], C2, mnL)); ps += (pA0[r] + pA1[r]) + (pB0[r] + pB1[r]); }
        { auto rr = __builtin_amdgcn_permlane32_swap(__float_as_uint(ps), __float_as_uint(ps), false, false); ps = __uint_as_float(rr[0]) + __uint_as_float(rr[1]); }
        const float rl = ps > 0.f ? 1.f / ps : 0.f;
        {
            float G[16], L[16], Lo[16];
#pragma unroll
            for (int q4 = 0; q4 < 4; ++q4) {
                G[q4] = ((pA0[4 * q4] + pA0[4 * q4 + 1]) + (pA0[4 * q4 + 2] + pA0[4 * q4 + 3])) * rl; L[q4] = pA0[4 * q4 + 3] * rl;
                G[4 + q4] = ((pA1[4 * q4] + pA1[4 * q4 + 1]) + (pA1[4 * q4 + 2] + pA1[4 * q4 + 3])) * rl; L[4 + q4] = pA1[4 * q4 + 3] * rl;
                G[8 + q4] = ((pB0[4 * q4] + pB0[4 * q4 + 1]) + (pB0[4 * q4 + 2] + pB0[4 * q4 + 3])) * rl; L[8 + q4] = pB0[4 * q4 + 3] * rl;
                G[12 + q4] = ((pB1[4 * q4] + pB1[4 * q4 + 1]) + (pB1[4 * q4 + 2] + pB1[4 * q4 + 3])) * rl; L[12 + q4] = pB1[4 * q4 + 3] * rl; }
#pragma unroll
            for (int i = 0; i < 16; ++i) Lo[i] = __shfl_xor(L[i], 32);
            float* ib = impb + ((size_t)headr * 64 + qq) * 32 + hi;
#pragma unroll
            for (int i = 0; i < 16; ++i) { const float prev = hi ? Lo[i] : (i > 0 ? Lo[i > 0 ? i - 1 : 0] : 0.f); ib[2 * i] = G[i] + prev; }
        }
        bf16x8 pa0, pa1, pa2, pa3, pb0, pb1, pb2, pb3;
        PK4(pA0, 0, pa0); PK4(pA0, 8, pa1); PK4(pA1, 0, pa2); PK4(pA1, 8, pa3);
        PK4(pB0, 0, pb0); PK4(pB0, 8, pb1); PK4(pB1, 0, pb2); PK4(pB1, 8, pb3);
#pragma unroll
        for (int d = 0; d < 4; ++d) o[d] = f32x16{};
        pv_tile(o, vbase, pa0, pa1, pa2, pa3); pv_tile(o, vbase + SHM_V, pb0, pb1, pb2, pb3);
        if (hi == 0) li_l[r32] = rl; asm volatile("s_waitcnt lgkmcnt(0)" ::: "memory");
#pragma unroll
        for (int r = 0; r < 16; ++r) { const int rw = crow(r, hi); const float f = li_l[rw] * GT[(tok0 + rw) * 24 + 0];
#pragma unroll
            for (int d0 = 0; d0 < 4; ++d0) o[d0][r] *= f; }
        asm volatile("s_waitcnt lgkmcnt(0)" ::: "memory");
    }
    __syncthreads();
    {
        const int qs = tid >> 3, jg = tid & 7; float s4[4];
#pragma unroll
        for (int jj = 0; jj < 4; ++jj) { const int j = 4 * jg + jj;
            float s = ((impb[(0 * 64 + qs) * 32 + j] + impb[(1 * 64 + qs) * 32 + j]) + impb[(2 * 64 + qs) * 32 + j]) + impb[(3 * 64 + qs) * 32 + j];
            if (j > own) s = -__builtin_inff(); else if (j == 0 || j == own || j == own - 1) s = __builtin_inff();
            s4[jj] = s; scoreb[qs * 32 + j] = s; }
        __syncthreads();
        unsigned bits = 0u;
#pragma unroll
        for (int jj = 0; jj < 4; ++jj) { const int j = 4 * jg + jj; const float s = s4[jj]; int rank = 0;
            for (int k = 0; k < 32; ++k) { const float sk = scoreb[qs * 32 + k]; rank += (sk > s || (sk == s && k < j)) ? 1 : 0; }
            if (rank < 8 && s > -__builtin_inff()) bits |= 1u << j; }
        bits |= __shfl_xor(bits, 1); bits |= __shfl_xor(bits, 2); bits |= __shfl_xor(bits, 4);
        if (jg == 0) selb[qs] = bits;
        __syncthreads();
    }
    const unsigned sel = selb[qq];
    char* accp = lds + L_ACC + tid * 16;
#pragma unroll
    for (int q = 0; q < 8; ++q) { const int d0 = q >> 1, r0 = 8 * (q & 1);
        u32x4 w; w.x = cvtpk(o[d0][r0], o[d0][r0 + 1]); w.y = cvtpk(o[d0][r0 + 2], o[d0][r0 + 3]); w.z = cvtpk(o[d0][r0 + 4], o[d0][r0 + 5]); w.w = cvtpk(o[d0][r0 + 6], o[d0][r0 + 7]);
        *(u32x4*)(accp + q * 8192) = w; }
    {
        const bf16* Q = bf.b16(WS_NQROT) + ((size_t)(b * 8 + head) * SEQ + posq) * HD;
#pragma unroll
        for (int d0 = 0; d0 < 8; ++d0) qr[d0] = *(const bf16x8*)(Q + d0 * 16 + hi * 8);
        float l;
        attn_pass<2>(lds, qr, bf.b16(WS_KS) + (size_t)bg * SEQ * HD, bf.b16(WS_VS) + (size_t)bg * SEQ * HD, 0, own + 1, posq, qlo, sel, own, o, l);
        ROW_RLI(l);
#pragma unroll
        for (int r = 0; r < 16; ++r) rli[r] *= GT[(tok0 + crow(r, hi)) * 24 + 1];
#pragma unroll
        for (int q = 0; q < 8; ++q) { const int d0 = q >> 1, r0 = 8 * (q & 1);
            const u32x4 a = *(const u32x4*)(accp + q * 8192); const unsigned aw[4] = {a.x, a.y, a.z, a.w}; unsigned ow[4];
#pragma unroll
            for (int k = 0; k < 4; ++k) ow[k] = cvtpk(bf2f(aw[k] & 0xffffu) + o[d0][r0 + 2 * k] * rli[r0 + 2 * k], bf2f(aw[k] >> 16) + o[d0][r0 + 2 * k + 1] * rli[r0 + 2 * k + 1]);
            *(u32x4*)(accp + q * 8192) = (u32x4){ow[0], ow[1], ow[2], ow[3]}; }
    }
    {
        float l;
        attn_pass<3>(lds, qr, bf.b16(WS_KW) + (size_t)bg * SEQ * HD, bf.b16(WS_VW) + (size_t)bg * SEQ * HD, own > 8 ? own - 8 : 0, own + 1, posq, qlo, 0u, own, o, l);
        ROW_RLI(l);
        const bf16* GZ = bf.b16(WS_GZ); bf16* T = bf.b16(WS_T);
#pragma unroll
        for (int r = 0; r < 16; ++r) rli[r] *= GT[(tok0 + crow(r, hi)) * 24 + 2];
#pragma unroll
        for (int q = 0; q < 8; ++q) { const int d0 = q >> 1, r0 = 8 * (q & 1);
            const u32x4 a = *(const u32x4*)(accp + q * 8192); const unsigned aw[4] = {a.x, a.y, a.z, a.w};
#pragma unroll
            for (int k = 0; k < 8; ++k) { const int r = r0 + k; const float av = (k & 1) ? bf2f(aw[k >> 1] >> 16) : bf2f(aw[k >> 1] & 0xffffu);
                const float v = av + o[d0][r] * rli[r]; const float vn = __shfl_xor(v, 1);
                const size_t base = (tok0 + crow(r, hi)) * 2048 + 1024 + head * 128 + d0 * 32 + r32;
                if ((r32 & 1) == 0) { const unsigned gz = *(const unsigned*)(GZ + base); *(unsigned*)(T + base) = cvtpk(v * bf2f(gz & 0xffffu), vn * bf2f(gz >> 16)); } } }
    }
}

struct ItemTable { unsigned short v[1024]; };
constexpr int moba_cost(int own) { return 4 * (own + 1) + 1; }
constexpr int nsa_cost(int own) { return 3 + (own + 1) + ((own + 1) < 9 ? (own + 1) : 9); }
constexpr ItemTable make_items() {
    ItemTable t{}; int n = 0;
    for (int c = 64; c >= 0; --c) {
        for (int own = 0; own < 8; ++own) if (moba_cost(own) == c) for (int bh = 0; bh < 64; ++bh) t.v[n++] = (unsigned short)((bh << 3) | own);
        for (int own = 0; own < 32; ++own) if (nsa_cost(own) == c) for (int bg = 0; bg < 16; ++bg) t.v[n++] = (unsigned short)(0x8000 | (bg << 5) | own);
    }
    return t;
}
__device__ const ItemTable ITEMS = make_items();

__device__ __forceinline__ void attn_phase(const Bufs& bf, char* lds) {
    const int tid = threadIdx.x;
    volatile int* itemw = (volatile int*)(lds + L_ITEM);
    unsigned* ctr = (unsigned*)(bf.ws + WS_CTL) + 64;
    for (;;) {
        if (tid == 0) *itemw = (int)atomicAdd(ctr, 1u);
        __syncthreads();
        const int it = __builtin_amdgcn_readfirstlane(*itemw);
        __syncthreads();
        if (it >= 1024) break;
        const unsigned e = ITEMS.v[it];
        if (e & 0x8000u) nsa_item(bf, lds, (int)((e >> 5) & 15u), (int)(e & 31u)); else moba_item(bf, lds, (int)((e >> 3) & 63u), (int)(e & 7u));
    }
}
#undef RESC
#undef ROW_RLI
#undef PK4
#undef KSWZ
#undef SBAR
}

__global__ void __launch_bounds__(256) naive_inproj(Bufs Bf) {
    __shared__ float hs[16][64];
    const int tid = threadIdx.x, dd = tid & 63, u = blockIdx.x * 4 + (tid >> 6), row0 = blockIdx.y * 16;
    const bool uv = u < 61;
    const int cb = !uv ? 0 : (u < 52 ? 128 * u : (u < 60 ? C_NZ + 128 * (u - 52) : C_NG));
    const bool v1ok = uv && (u < 60 || dd < 24), v2ok = uv && u < 60;
    const int c1 = cb + dd, c2 = cb + dd + 64;
    float a1[16], a2[16];
#pragma unroll
    for (int r = 0; r < 16; ++r) { a1[r] = 0.f; a2[r] = 0.f; }
    const bf16* H = Bf.b16(WS_H);
    for (int k0 = 0; k0 < 2048; k0 += 64) {
        __syncthreads();
        for (int i = tid; i < 16 * 64; i += 256) hs[i >> 6][i & 63] = bf2f(H[(size_t)(row0 + (i >> 6)) * 2048 + k0 + (i & 63)]);
        __syncthreads();
        for (int k = 0; k < 64; ++k) {
            const float w1 = v1ok ? Bf.w_in[(size_t)(k0 + k) * INC + c1] : 0.f, w2 = v2ok ? Bf.w_in[(size_t)(k0 + k) * INC + c2] : 0.f;
#pragma unroll
            for (int r = 0; r < 16; ++r) { const float h = hs[r][k]; a1[r] += h * w1; a2[r] += h * w2; }
        }
    }
    if (!uv) return;
    const float* COS = Bf.f32(WS_COS); const float* SIN = Bf.f32(WS_SIN);
    for (int r = 0; r < 16; ++r) {
        const int row = row0 + r, b = row >> 11, s = row & 2047; float v1 = a1[r], v2 = a2[r];
        bf16* dst = nullptr; int nh = 8, head = 0; bool rope = false; bf16* dst_raw = nullptr;
        if (u < 8) { dst = Bf.b16(WS_QM); head = u; rope = true; }
        else if (u < 16) { dst = Bf.b16(WS_KM); head = u - 8; rope = true; }
        else if (u < 24) { dst = Bf.b16(WS_VM); head = u - 16; }
        else if (u < 32) { bf16* gz = Bf.b16(WS_GZ) + (size_t)row * 2048 + (u - 24) * 128; gz[dd] = (bf16)f2bf(silu_f(v1)); gz[dd + 64] = (bf16)f2bf(silu_f(v2)); continue; }
        else if (u < 40) { dst = Bf.b16(WS_NQROT); dst_raw = Bf.b16(WS_NQRAW); head = u - 32; rope = true; }
        else if (u < 42) { dst = Bf.b16(WS_KCIN); head = u - 40; nh = 2; }
        else if (u < 44) { dst = Bf.b16(WS_VCIN); head = u - 42; nh = 2; }
        else if (u < 46) { dst = Bf.b16(WS_KS); head = u - 44; nh = 2; rope = true; }
        else if (u < 48) { dst = Bf.b16(WS_VS); head = u - 46; nh = 2; }
        else if (u < 50) { dst = Bf.b16(WS_KW); head = u - 48; nh = 2; rope = true; }
        else if (u < 52) { dst = Bf.b16(WS_VW); head = u - 50; nh = 2; }
        else if (u < 60) { bf16* gz = Bf.b16(WS_GZ) + (size_t)row * 2048 + 1024 + (u - 52) * 128; gz[dd] = (bf16)f2bf(silu_f(v1)); gz[dd + 64] = (bf16)f2bf(silu_f(v2)); continue; }
        else { if (dd < 24) Bf.f32(WS_GATES)[(size_t)row * 24 + dd] = sigmoid_f(v1); continue; }
        const size_t o = ((size_t)(b * nh + head) * SEQ + s) * HD + dd;
        if (dst_raw) { dst_raw[o] = (bf16)f2bf(v1); dst_raw[o + 64] = (bf16)f2bf(v2); }
        if (rope) { const float c = COS[(size_t)row * 64 + dd], sn = SIN[(size_t)row * 64 + dd]; const float o1 = v1 * c - v2 * sn, o2 = v2 * c + v1 * sn; v1 = o1; v2 = o2; }
        dst[o] = (bf16)f2bf(v1); dst[o + 64] = (bf16)f2bf(v2);
    }
}
__global__ void __launch_bounds__(256) naive_kmean(Bufs Bf) {
    const int i = blockIdx.x * 256 + threadIdx.x; if (i >= 8 * 8 * 8 * 128) return;
    const int d = i & 127, blk = (i >> 7) & 7, bh = i >> 10;
    const bf16* K = Bf.b16(WS_KM) + ((size_t)bh * SEQ + blk * 256) * HD + d; float s = 0.f;
    for (int r = 0; r < 256; ++r) s += bf2f(K[(size_t)r * HD]);
    Bf.f32(WS_KMS)[i] = s;
}
__global__ void __launch_bounds__(256) naive_compress(Bufs Bf) {
    __shared__ float in[4096]; __shared__ float hid[256];
    const int i = blockIdx.x, bg = blockIdx.y, kv = blockIdx.z, tid = threadIdx.x;
    bf16* outp = Bf.b16(kv ? WS_VC : WS_KC) + ((size_t)bg * 128 + i) * 128;
    if (i == 127) { if (tid < 128) outp[tid] = 0; return; }
    const bf16* src = Bf.b16(kv ? WS_VCIN : WS_KCIN) + ((size_t)bg * SEQ + 16 * i) * HD;
    const float* pe = kv ? Bf.pe_cv : Bf.pe_ck; const float* w1 = kv ? Bf.w_cv1 : Bf.w_ck1; const float* w2 = kv ? Bf.w_cv2 : Bf.w_ck2;
    for (int k = tid; k < 4096; k += 256) in[k] = bf2f(src[k]) + pe[k];
    __syncthreads();
    float a = 0.f;
    for (int k = 0; k < 4096; ++k) a += in[k] * w1[(size_t)k * 256 + tid];
    hid[tid] = silu_f(a);
    __syncthreads();
    if (tid < 128) { float o = 0.f; for (int n = 0; n < 256; ++n) o += hid[n] * w2[n * 128 + tid]; outp[tid] = (bf16)f2bf(o); }
}

#define WAVE_LDS_SYNC() asm volatile("s_waitcnt lgkmcnt(0)" ::: "memory")
__device__ __forceinline__ void na_load_q(const bf16* q, float* qf, int lane) { qf[lane] = bf2f(q[lane]); qf[lane + 64] = bf2f(q[lane + 64]); WAVE_LDS_SYNC(); }
__device__ __forceinline__ void na_scores(const float* qf, const bf16* K, int kb, bool valid, int lane, float* sc, int* kidx, int& n) {
    float s = -__builtin_inff();
    if (valid) { const bf16* kr = K + (size_t)(kb + lane) * HD; float a = 0.f;
        for (int d = 0; d < 128; d += 8) { const u32x4 w = *(const u32x4*)(kr + d);
            a += qf[d] * bf2f(w.x & 0xffffu) + qf[d + 1] * bf2f(w.x >> 16) + qf[d + 2] * bf2f(w.y & 0xffffu) + qf[d + 3] * bf2f(w.y >> 16)
               + qf[d + 4] * bf2f(w.z & 0xffffu) + qf[d + 5] * bf2f(w.z >> 16) + qf[d + 6] * bf2f(w.w & 0xffffu) + qf[d + 7] * bf2f(w.w >> 16); }
        s = a * SCALE; }
    sc[n + lane] = s; kidx[n + lane] = kb + lane; n += 64;
}
__device__ __forceinline__ float na_finish(float* sc, const int* kidx, int n, const bf16* V, int lane, float& o0, float& o1) {
    WAVE_LDS_SYNC();
    float m = -__builtin_inff();
    for (int i = lane; i < n; i += 64) m = fmaxf(m, sc[i]);
    m = wave_max(m);
    if (m == -__builtin_inff()) { o0 = 0.f; o1 = 0.f; return 0.f; }
    float l = 0.f;
    for (int i = lane; i < n; i += 64) { const float p = __expf(sc[i] - m); sc[i] = p; l += p; }
    l = wave_sum(l);
    WAVE_LDS_SYNC();
    float a0 = 0.f, a1 = 0.f;
    for (int i = 0; i < n; ++i) { const float p = sc[i]; if (p != 0.f) { const bf16* vr = V + (size_t)kidx[i] * HD; a0 += p * bf2f(vr[lane]); a1 += p * bf2f(vr[lane + 64]); } }
    const float rl = 1.f / l; o0 = a0 * rl; o1 = a1 * rl; return l;
}
__global__ void __launch_bounds__(256) naive_moba(Bufs Bf) {
    __shared__ float sc_[4][1024]; __shared__ int kx_[4][1024]; __shared__ float qf_[4][128];
    const int w = threadIdx.x >> 6, lane = threadIdx.x & 63;
    const int q = blockIdx.x * 4 + w, bh = blockIdx.y, b = bh >> 3, h = bh & 7;
    float* sc = sc_[w]; int* kidx = kx_[w]; float* qf = qf_[w];
    const bf16* Q = Bf.b16(WS_QM) + ((size_t)bh * SEQ + q) * HD; const bf16* K = Bf.b16(WS_KM) + (size_t)bh * SEQ * HD; const bf16* V = Bf.b16(WS_VM) + (size_t)bh * SEQ * HD;
    na_load_q(Q, qf, lane);
    const int own = q >> 8;
    float g = -__builtin_inff();
    if (lane < own) { const float* km = Bf.f32(WS_KMS) + ((size_t)bh * 8 + lane) * 128; float a = 0.f; for (int d = 0; d < 128; ++d) a += qf[d] * km[d]; g = a; }
    int rank = 0;
    for (int k = 0; k < 8; ++k) { const float gk = __shfl(g, k); rank += (gk > g || (gk == g && k < lane)) ? 1 : 0; }
    const bool sel = (lane < own) && rank < 3;
    const unsigned long long selm = __ballot(sel);
    int n = 0;
    for (int j = 0; j < own; ++j) if ((selm >> j) & 1ull) for (int c = 0; c < 4; ++c) na_scores(qf, K, j * 256 + c * 64, true, lane, sc, kidx, n);
    for (int c = 0; c < 4; ++c) { const int kb = own * 256 + c * 64; if (kb <= q) na_scores(qf, K, kb, kb + lane <= q, lane, sc, kidx, n); }
    float o0, o1; na_finish(sc, kidx, n, V, lane, o0, o1);
    const int row = b * SEQ + q; const bf16* gz = Bf.b16(WS_GZ) + (size_t)row * 2048 + h * 128; bf16* T = Bf.b16(WS_T) + (size_t)row * 2048 + h * 128;
    T[lane] = (bf16)f2bf(o0 * bf2f(gz[lane])); T[lane + 64] = (bf16)f2bf(o1 * bf2f(gz[lane + 64]));
}
__global__ void __launch_bounds__(128) naive_nsa(Bufs Bf) {
    __shared__ float sc_[2][640]; __shared__ int kx_[2][640]; __shared__ float qf_[2][128];
    const int w = threadIdx.x >> 6, lane = threadIdx.x & 63;
    const int q = blockIdx.x * 2 + w, bg = blockIdx.y, b = bg >> 1, g = bg & 1;
    float* sc = sc_[w]; int* kidx = kx_[w]; float* qf = qf_[w];
    const int row = b * SEQ + q, own = q >> 6;
    const bf16* KC = Bf.b16(WS_KC) + (size_t)bg * 128 * HD; const bf16* VC = Bf.b16(WS_VC) + (size_t)bg * 128 * HD;
    const bf16* KS = Bf.b16(WS_KS) + (size_t)bg * SEQ * HD; const bf16* VS = Bf.b16(WS_VS) + (size_t)bg * SEQ * HD;
    const bf16* KW = Bf.b16(WS_KW) + (size_t)bg * SEQ * HD; const bf16* VW = Bf.b16(WS_VW) + (size_t)bg * SEQ * HD;
    float oc0[4], oc1[4]; float imp = 0.f;
    for (int r = 0; r < 4; ++r) {
        const int head = g * 4 + r;
        na_load_q(Bf.b16(WS_NQRAW) + ((size_t)(b * 8 + head) * SEQ + q) * HD, qf, lane);
        int n = 0;
        for (int c = 0; c < 2; ++c) { const int key = c * 64 + lane; na_scores(qf, KC, c * 64, key < 127 && 16 * key + 31 <= q, lane, sc, kidx, n); }
        const float l = na_finish(sc, kidx, n, VC, lane, oc0[r], oc1[r]);
        if (l > 0.f && lane < 32) { const float rl = 1.f / l; float a = 0.f;
            for (int t = 4 * lane - 1; t <= 4 * lane + 3; ++t) if (t >= 0 && t < 127) a += sc[t] * rl;
            imp += a; }
        WAVE_LDS_SYNC();
    }
    float s = -__builtin_inff();
    if (lane < 32) { if (lane > own) s = -__builtin_inff(); else if (lane == 0 || lane == own || lane == own - 1) s = __builtin_inff(); else s = imp; }
    int rank = 0;
    for (int k = 0; k < 32; ++k) { const float sk = __shfl(s, k); rank += (sk > s || (sk == s && k < lane)) ? 1 : 0; }
    const bool sel = lane < 32 && rank < 8 && s > -__builtin_inff();
    const unsigned long long selm = __ballot(sel);
    const float* gt = Bf.f32(WS_GATES) + (size_t)row * 24 + g * 12;
    for (int r = 0; r < 4; ++r) {
        const int head = g * 4 + r;
        na_load_q(Bf.b16(WS_NQROT) + ((size_t)(b * 8 + head) * SEQ + q) * HD, qf, lane);
        int n = 0;
        for (int j = 0; j < 32; ++j) if ((selm >> j) & 1ull) na_scores(qf, KS, j * 64, j * 64 + lane <= q, lane, sc, kidx, n);
        float os0, os1; na_finish(sc, kidx, n, VS, lane, os0, os1);
        WAVE_LDS_SYNC();
        n = 0;
        const int lo = q - 511 > 0 ? q - 511 : 0;
        for (int kb = (lo >> 6) << 6; kb <= q; kb += 64) { const int key = kb + lane; na_scores(qf, KW, kb, key <= q && key > q - 512, lane, sc, kidx, n); }
        float ow0, ow1; na_finish(sc, kidx, n, VW, lane, ow0, ow1);
        WAVE_LDS_SYNC();
        const float g0 = gt[r * 3 + 0], g1 = gt[r * 3 + 1], g2 = gt[r * 3 + 2];
        const float v0 = g0 * oc0[r] + g1 * os0 + g2 * ow0, v1 = g0 * oc1[r] + g1 * os1 + g2 * ow1;
        const bf16* gz = Bf.b16(WS_GZ) + (size_t)row * 2048 + 1024 + head * 128; bf16* T = Bf.b16(WS_T) + (size_t)row * 2048 + 1024 + head * 128;
        T[lane] = (bf16)f2bf(v0 * bf2f(gz[lane])); T[lane + 64] = (bf16)f2bf(v1 * bf2f(gz[lane + 64]));
    }
}
__global__ void __launch_bounds__(256) naive_tnorm(Bufs Bf) {
    const int lane = threadIdx.x & 63, row = blockIdx.x * 4 + (threadIdx.x >> 6);
    bf16* T = Bf.b16(WS_T) + (size_t)row * 2048;
    for (int half = 0; half < 2; ++half) {
        bf16* p = T + half * 1024 + lane * 16; u32x4 a = *(u32x4*)p, c = *(u32x4*)(p + 8); unsigned w[8] = {a.x, a.y, a.z, a.w, c.x, c.y, c.z, c.w};
        float s = 0.f;
#pragma unroll
        for (int i = 0; i < 8; ++i) { const float lo = bf2f(w[i] & 0xffffu), hi = bf2f(w[i] >> 16); s += lo * lo + hi * hi; }
        const float rstd = 1.0f / sqrtf(wave_sum(s) * (1.f / 1024.f) + EPS);
#pragma unroll
        for (int i = 0; i < 8; ++i) w[i] = pk2(bf2f(w[i] & 0xffffu) * rstd, bf2f(w[i] >> 16) * rstd);
        *(u32x4*)p = (u32x4){w[0], w[1], w[2], w[3]}; *(u32x4*)(p + 8) = (u32x4){w[4], w[5], w[6], w[7]};
    }
}
__global__ void __launch_bounds__(256) naive_outproj(Bufs Bf) {
    __shared__ float ys[16][64];
    const int tid = threadIdx.x, col = blockIdx.x * 256 + tid, row0 = blockIdx.y * 16;
    float a[16];
#pragma unroll
    for (int r = 0; r < 16; ++r) a[r] = 0.f;
    const bf16* T = Bf.b16(WS_T);
    for (int k0 = 0; k0 < 2048; k0 += 64) {
        __syncthreads();
        for (int i = tid; i < 16 * 64; i += 256) ys[i >> 6][i & 63] = bf2f(T[(size_t)(row0 + (i >> 6)) * 2048 + k0 + (i & 63)]);
        __syncthreads();
        for (int k = 0; k < 64; ++k) { const int e = k0 + k; const float w = Bf.w_out[(size_t)e * 2048 + col] * (e < 1024 ? Bf.g_out_moba[e] : Bf.g_out_nsa[e - 1024]);
#pragma unroll
            for (int r = 0; r < 16; ++r) a[r] += ys[r][k] * w; }
    }
    for (int r = 0; r < 16; ++r) { const size_t o = (size_t)(row0 + r) * 2048 + col; Bf.out[o] = Bf.x[o] + a[r]; }
}
__device__ __forceinline__ void final_norm_row(const Bufs& Bf, int m, int lane) {
    float* xr = Bf.out + (size_t)m * DM + lane * 8; f32x4 v[8]; float s = 0.f;
#pragma unroll
    for (int j = 0; j < 4; ++j) { v[2 * j] = *(const f32x4*)(xr + j * 512); v[2 * j + 1] = *(const f32x4*)(xr + j * 512 + 4); }
#pragma unroll
    for (int j = 0; j < 8; ++j) s += (v[j].x * v[j].x + v[j].y * v[j].y) + (v[j].z * v[j].z + v[j].w * v[j].w);
    const float rstd = 1.0f / sqrtf(wave_sum(s) * (1.f / DM) + EPS);
#pragma unroll
    for (int j = 0; j < 4; ++j) { const f32x4 g0 = *(const f32x4*)(Bf.g_final + j * 512 + lane * 8), g1 = *(const f32x4*)(Bf.g_final + j * 512 + lane * 8 + 4);
        *(f32x4*)(xr + j * 512) = v[2 * j] * rstd * g0; *(f32x4*)(xr + j * 512 + 4) = v[2 * j + 1] * rstd * g1; }
}
__global__ void __launch_bounds__(256) naive_final(Bufs Bf) { final_norm_row(Bf, blockIdx.x * 4 + (threadIdx.x >> 6), threadIdx.x & 63); }

#define LAS __attribute__((address_space(3)))
#define XB_TMO      128
#define XB_XCNT(j)  (256  + 64 * (j))
#define XB_XSUB(j)  (1280 + 64 * (j))
#define XB_XGEN(j)  (2304 + 64 * (j))
#define XB_TOP      3328
#define XB_TOPGEN   3392
#define XCD_BAR_WORDS 3456
#define XB_SPIN_CAP (1u << 18)

__device__ __forceinline__ unsigned xb_ld(unsigned* p)              { return __hip_atomic_load(p, __ATOMIC_RELAXED, __HIP_MEMORY_SCOPE_AGENT); }
__device__ __forceinline__ unsigned xb_add(unsigned* p, unsigned v) { return __hip_atomic_fetch_add(p, v, __ATOMIC_RELAXED, __HIP_MEMORY_SCOPE_AGENT); }
__device__ __forceinline__ unsigned xb_xcc_id() { return (unsigned)__builtin_amdgcn_s_getreg((3 << 11) | 20) & 0xFu; }
#define XB_SPIN(cond, bar) do { unsigned _sp = 0; while (cond) { __builtin_amdgcn_s_sleep(1); \
    if ((++_sp & 255u) == 0u) { if (xb_ld(&(bar)[XB_TMO])) break; if (_sp > XB_SPIN_CAP) { atomicAdd(&(bar)[XB_TMO], 1u); break; } } } } while (0)

struct XcdBarrier {
    unsigned* bar; unsigned x;
    volatile LAS unsigned* st;
};

__device__ __forceinline__ XcdBarrier xcd_barrier_post(unsigned* bar, volatile LAS unsigned* st) {
    XcdBarrier b; b.bar = bar; b.x = xb_xcc_id(); b.st = st;
    if (threadIdx.x == 0) (void)xb_add(&bar[XB_XCNT(b.x)], 1u);
    return b;
}
__device__ __forceinline__ void xcd_barrier_complete(unsigned* bar, unsigned x, unsigned& nloc, unsigned& nx) {
    const unsigned G = gridDim.x * gridDim.y * gridDim.z;
    unsigned sum, cnt, mine, sp = 0u;
    for (;;) {
        sum = 0u; cnt = 0u; mine = 0u;
#pragma unroll
        for (unsigned j = 0; j < 16; ++j) { const unsigned c = xb_ld(&bar[XB_XCNT(j)]); sum += c; cnt += (c > 0u) ? 1u : 0u; mine = (j == x) ? c : mine; }
        if (sum == G) break;
        __builtin_amdgcn_s_sleep(1);
        if ((++sp & 255u) == 0u) { if (xb_ld(&bar[XB_TMO])) break; if (sp > XB_SPIN_CAP) { atomicAdd(&bar[XB_TMO], 1u); break; } }
    }
    nloc = mine > 0u ? mine : 1u; nx = cnt > 0u ? cnt : 1u;
}

__device__ __forceinline__ void xcd_barrier(const XcdBarrier& b) {
    asm volatile("s_waitcnt vmcnt(0)" ::: "memory");
    __syncthreads();
    if (threadIdx.x == 0) {
        unsigned* bar = b.bar;
        __builtin_amdgcn_s_waitcnt(0);
        unsigned nloc = b.st[0], nx = b.st[1];
        if (nloc == 0u) { xcd_barrier_complete(bar, b.x, nloc, nx); b.st[0] = nloc; b.st[1] = nx; }
        const unsigned old = xb_add(&bar[XB_XSUB(b.x)], 1u);
        const unsigned gen = old / nloc;
        if (old + 1u == (gen + 1u) * nloc) {
            __builtin_amdgcn_fence(__ATOMIC_RELEASE, "agent");
            asm volatile("s_waitcnt vmcnt(0)" ::: "memory");
            const unsigned og = xb_add(&bar[XB_TOP], 1u);
            const unsigned tg = og / nx;
            if (og + 1u == (tg + 1u) * nx) xb_add(&bar[XB_TOPGEN], 1u);
            else XB_SPIN(xb_ld(&bar[XB_TOPGEN]) == tg, bar);
            __builtin_amdgcn_fence(__ATOMIC_ACQUIRE, "agent");
            xb_add(&bar[XB_XGEN(b.x)], 1u);
            asm volatile("s_waitcnt vmcnt(0)" ::: "memory");
        } else {
            XB_SPIN(xb_ld(&bar[XB_XGEN(b.x)]) == gen, bar);
            __builtin_amdgcn_fence(__ATOMIC_ACQUIRE, "agent");
            asm volatile("s_waitcnt vmcnt(0)" ::: "memory");
        }
    }
    __syncthreads();
}

constexpr int L_HID = 0;
__device__ __forceinline__ void compress_phase(const Bufs& bf, char* lds, int wg, int G) {
    const int tid = att::opaque_tid(), lane = tid & 63, wid = __builtin_amdgcn_readfirstlane(tid >> 6), l15 = lane & 15, l4 = lane >> 4;
    bf16* hidb = (bf16*)(lds + L_HID);
    for (int it = wg; it < 256; it += G) {
        const int kv = it >> 7, bg = (it >> 3) & 15, mc = it & 7;
        const bf16* src = bf.b16(kv ? WS_VCIN : WS_KCIN) + (size_t)bg * SEQ * HD;
        int i = 16 * mc + l15; if (i > 126) i = 126;
        const bf16* arow = src + (size_t)i * 2048 + l4 * 8;
        const bf16* b0p = bf.b16(WS_WC1T) + (size_t)kv * 256 * 4096 + (size_t)(32 * wid + l15) * 4096 + l4 * 8; const bf16* b1p = b0p + 16 * 4096;
        f32x4 acc0 = {0.f, 0.f, 0.f, 0.f}, acc1 = acc0;
#pragma unroll 8
        for (int ks = 0; ks < 128; ++ks) {
            const bf16x8 a = *(const bf16x8*)(arow + 32 * ks), b0 = *(const bf16x8*)(b0p + 32 * ks), b1 = *(const bf16x8*)(b1p + 32 * ks);
            acc0 = __builtin_amdgcn_mfma_f32_16x16x32_bf16(a, b0, acc0, 0, 0, 0); acc1 = __builtin_amdgcn_mfma_f32_16x16x32_bf16(a, b1, acc1, 0, 0, 0); }
        const float* cb = bf.f32(WS_CBIAS) + (size_t)kv * 64 * 256 + 32 * wid + l15; float bias0 = 0.f, bias1 = 0.f;
        for (int c = 0; c < 64; ++c) { bias0 += cb[c * 256]; bias1 += cb[c * 256 + 16]; }
#pragma unroll
        for (int r = 0; r < 4; ++r) { const int row = 4 * l4 + r;
            hidb[row * 264 + 32 * wid + l15] = (bf16)f2bf(silu_f(acc0[r] + bias0)); hidb[row * 264 + 32 * wid + 16 + l15] = (bf16)f2bf(silu_f(acc1[r] + bias1)); }
        __syncthreads();
        const bf16* w2p = bf.b16(WS_WC2T) + (size_t)kv * 128 * 256 + (size_t)(16 * wid + l15) * 256 + l4 * 8;
        f32x4 oacc = {0.f, 0.f, 0.f, 0.f};
#pragma unroll
        for (int ks = 0; ks < 8; ++ks) { const bf16x8 a = *(const bf16x8*)(hidb + l15 * 264 + 32 * ks + 8 * l4), bb = *(const bf16x8*)(w2p + 32 * ks);
            oacc = __builtin_amdgcn_mfma_f32_16x16x32_bf16(a, bb, oacc, 0, 0, 0); }
        bf16* outp = bf.b16(kv ? WS_VC : WS_KC) + (size_t)bg * 128 * HD + 16 * wid + l15;
#pragma unroll
        for (int r = 0; r < 4; ++r) { const int io = 16 * mc + 4 * l4 + r; outp[(size_t)io * HD] = io == 127 ? (bf16)0 : (bf16)f2bf(oacc[r]); }
        __syncthreads();
    }
}
__device__ __forceinline__ void tnorm_row(const Bufs& bf, int row, int lane) {
    bf16* T = bf.b16(WS_T) + (size_t)row * 2048;
#pragma unroll
    for (int half = 0; half < 2; ++half) {
        bf16* p = T + half * 1024 + lane * 16; const u32x4 a = *(u32x4*)p, c = *(u32x4*)(p + 8); unsigned w[8] = {a.x, a.y, a.z, a.w, c.x, c.y, c.z, c.w};
        float s = 0.f;
#pragma unroll
        for (int i = 0; i < 8; ++i) { const float lo = bf2f(w[i] & 0xffffu), hi = bf2f(w[i] >> 16); s += lo * lo + hi * hi; }
        const float rstd = 1.0f / sqrtf(wave_sum(s) * (1.f / 1024.f) + EPS);
#pragma unroll
        for (int i = 0; i < 8; ++i) w[i] = pk2(bf2f(w[i] & 0xffffu) * rstd, bf2f(w[i] >> 16) * rstd);
        *(u32x4*)p = (u32x4){w[0], w[1], w[2], w[3]}; *(u32x4*)(p + 8) = (u32x4){w[4], w[5], w[6], w[7]};
    }
}

constexpr int NWAVES = 8;
constexpr int LDS_BYTES = 147456;
constexpr int L_MISC = 139264;
constexpr int CW_BAR = 4096;
struct Args { Bufs bf; int ph_lo, ph_hi; };
__global__ void __launch_bounds__(NWAVES * 64, 2) mk_fwd(Args args) {
    extern __shared__ __attribute__((aligned(16))) unsigned char lds[];
    const int tid = threadIdx.x, lane = tid & 63, wave = __builtin_amdgcn_readfirstlane(tid >> 6);
    const int G = gridDim.x, gw = blockIdx.x * NWAVES + wave, NGW = G * NWAVES;
    const int lo = args.ph_lo, hi = args.ph_hi;
    volatile LAS unsigned* MISC = (volatile LAS unsigned*)((LAS unsigned char*)lds + L_MISC);
    if (tid < 16) MISC[tid] = 0u;
    __syncthreads();
    unsigned* ctl = (unsigned*)(args.bf.ws + WS_CTL);
    XcdBarrier bar; bar.bar = ctl + CW_BAR; bar.x = 0; bar.st = nullptr;
    if (hi - lo > 1) bar = xcd_barrier_post(ctl + CW_BAR, MISC + 8);
#define IN(k) (lo <= (k) && (k) < hi)
#define SEAM(k) do { if (IN(k) && IN((k) + 1)) xcd_barrier(bar); } while (0)
    if (IN(0)) p0_prologue(args.bf, gw, NGW, lane, (float*)(lds + wave * 16384));
    SEAM(0);
    if (IN(1)) {
        pg8::Gemm g{args.bf.b16(WS_H), args.bf.b16(WS_WINT), M, NPAD, 2048}; pg8::StaticOrder S; S.init(M, NPAD, G, (int)blockIdx.x);
        EpiIn E{args.bf};
        pg8::gemm_phase<EpiIn, pg8::StaticOrder, true, true>((PG8_LAS unsigned char*)lds, g, S, E);
    }
    SEAM(1);
    if (IN(2)) compress_phase(args.bf, (char*)lds, (int)blockIdx.x, G);
    SEAM(2);
    if (IN(3)) att::attn_phase(args.bf, (char*)lds);
    SEAM(3);
    if (IN(4)) for (int m = gw; m < M; m += NGW) tnorm_row(args.bf, m, lane);
    SEAM(4);
    if (IN(5)) {
        pg8::Gemm g{args.bf.b16(WS_T), args.bf.b16(WS_WOUTT), M, DM, 2048}; pg8::StaticOrder S; S.init(M, DM, G, (int)blockIdx.x);
        EpiOut E{args.bf.x, args.bf.out};
        pg8::gemm_phase<EpiOut, pg8::StaticOrder, true, true>((PG8_LAS unsigned char*)lds, g, S, E);
    }
    SEAM(5);
    if (IN(6)) for (int m = gw; m < M; m += NGW) final_norm_row(args.bf, m, lane);
#undef IN
#undef SEAM
}

extern "C" void kernel_launch(void* const* d_in, const int* in_sizes, int n_in, void* d_out, int out_size, void* d_ws, size_t ws_size, hipStream_t stream) {
    static int grid = 0;
    if (grid == 0) {
        if (n_in != 14 || in_sizes[0] != M * DM || out_size != M * DM || ws_size < WS_END) {
            fprintf(stderr, "kernel_launch: unexpected shapes: n_in %d in0 %d out %d ws %zu (need %zu)\n", n_in, n_in > 0 ? in_sizes[0] : -1, out_size, ws_size, (size_t)WS_END); grid = -1; return; }
        int dev = 0, cus = 0;
        if (hipGetDevice(&dev) != hipSuccess || hipDeviceGetAttribute(&cus, hipDeviceAttributeMultiprocessorCount, dev) != hipSuccess) { grid = -1; return; }
        if (hipFuncSetAttribute((const void*)mk_fwd, hipFuncAttributeMaxDynamicSharedMemorySize, LDS_BYTES) != hipSuccess) { fprintf(stderr, "kernel_launch: hipFuncSetAttribute failed\n"); grid = -1; return; }
        grid = cus;
    }
    if (grid < 0) return;
    (void)hipMemsetAsync((char*)d_ws + WS_CTL, 0, CTL_ZERO_BYTES, stream);
    Args a{};
    a.bf.x = (const float*)d_in[0]; a.bf.pos = (const int*)d_in[1]; a.bf.w_in = (const float*)d_in[2]; a.bf.g_norm = (const float*)d_in[3];
    a.bf.pe_ck = (const float*)d_in[4]; a.bf.pe_cv = (const float*)d_in[5]; a.bf.w_ck1 = (const float*)d_in[6]; a.bf.w_ck2 = (const float*)d_in[7];
    a.bf.w_cv1 = (const float*)d_in[8]; a.bf.w_cv2 = (const float*)d_in[9]; a.bf.g_out_moba = (const float*)d_in[10]; a.bf.g_out_nsa = (const float*)d_in[11];
    a.bf.w_out = (const float*)d_in[12]; a.bf.g_final = (const float*)d_in[13]; a.bf.out = (float*)d_out; a.bf.ws = (unsigned char*)d_ws;
#ifndef MK_N_LAUNCHES
#define MK_N_LAUNCHES 1
#endif
    if (MK_N_LAUNCHES == 1) { a.ph_lo = 0; a.ph_hi = 7; hipLaunchKernelGGL(mk_fwd, dim3(grid), dim3(NWAVES * 64), LDS_BYTES, stream, a); }
    else for (int ph = 0; ph < 7; ++ph) { a.ph_lo = ph; a.ph_hi = ph + 1; hipLaunchKernelGGL(mk_fwd, dim3(grid), dim3(NWAVES * 64), LDS_BYTES, stream, a); }
}
```

```cpp
#include <hip/hip_runtime.h>
#include <cstdio>
#include <cstdint>

constexpr int NB = 8, SEQ = 2048, DM = 2048, M = NB * SEQ;
constexpr int HD = 128;
constexpr int INC = 7704;
constexpr int C_NG = 6656, C_NZ = 6680;
constexpr float EPS = 1e-6f;
constexpr float SCALE = 0.08838834764831845f;
constexpr int NPAD = 7936;

typedef unsigned short bf16;
typedef short bf16x8 __attribute__((ext_vector_type(8)));
typedef float f32x4 __attribute__((ext_vector_type(4)));
typedef float f32x16 __attribute__((ext_vector_type(16)));
typedef unsigned u32x4 __attribute__((ext_vector_type(4)));
typedef unsigned u32x2 __attribute__((ext_vector_type(2)));

__device__ __forceinline__ unsigned f2bf(float f) { unsigned u = __builtin_bit_cast(unsigned, f); return (u + 0x7fffu + ((u >> 16) & 1u)) >> 16; }
__device__ __forceinline__ unsigned pk2(float lo, float hi) { return f2bf(lo) | (f2bf(hi) << 16); }
__device__ __forceinline__ float bf2f(unsigned b) { return __builtin_bit_cast(float, b << 16); }
__device__ __forceinline__ float silu_f(float v) { return v / (1.f + __expf(-v)); }
__device__ __forceinline__ float sigmoid_f(float v) { return 1.f / (1.f + __expf(-v)); }
__device__ __forceinline__ float wave_sum(float v) {
#pragma unroll
    for (int o = 1; o < 64; o <<= 1) v += __shfl_xor(v, o);
    return v;
}
__device__ __forceinline__ float wave_max(float v) {
#pragma unroll
    for (int o = 1; o < 64; o <<= 1) v = fmaxf(v, __shfl_xor(v, o));
    return v;
}

constexpr size_t MiB = 1u << 20;
constexpr size_t WS_CTL = 0, CTL_ZERO_BYTES = 1 * MiB;
constexpr size_t WS_KMS = 512 * 1024;
constexpr size_t WS_WINT = 2 * MiB;
constexpr size_t WS_WOUTT = 34 * MiB;
constexpr size_t WS_WC1T = 42 * MiB;
constexpr size_t WS_WC2T = 46 * MiB;
constexpr size_t WS_CBIAS = 46 * MiB + 256 * 1024;
constexpr size_t WS_KC = 46 * MiB + 512 * 1024;
constexpr size_t WS_VC = 47 * MiB;
constexpr size_t WS_GATES = 48 * MiB;
constexpr size_t WS_COS = 54 * MiB, WS_SIN = 58 * MiB;
constexpr size_t WS_H = 64 * MiB;
constexpr size_t WS_T = WS_H;
constexpr size_t WS_QM = 128 * MiB, WS_KM = 160 * MiB, WS_VM = 192 * MiB;
constexpr size_t WS_GZ = 224 * MiB;
constexpr size_t WS_NQROT = 288 * MiB, WS_NQRAW = 320 * MiB;
constexpr size_t WS_KCIN = 352 * MiB, WS_VCIN = 360 * MiB, WS_KS = 368 * MiB, WS_VS = 376 * MiB, WS_KW = 384 * MiB, WS_VW = 392 * MiB;
constexpr size_t WS_ACC = 400 * MiB;
constexpr size_t WS_END = 464 * MiB;

struct Bufs {
    const float* x; const int* pos; const float *w_in, *g_norm, *pe_ck, *pe_cv, *w_ck1, *w_ck2, *w_cv1, *w_cv2, *g_out_moba, *g_out_nsa, *w_out, *g_final;
    float* out; unsigned char* ws;
    __device__ __forceinline__ bf16* b16(size_t off) const { return (bf16*)(ws + off); }
    __device__ __forceinline__ float* f32(size_t off) const { return (float*)(ws + off); }
};

__device__ const float INV_FREQ[64] = {
    1.000000000e+00f, 8.659643531e-01f, 7.498942018e-01f, 6.493816376e-01f, 5.623413324e-01f, 4.869675338e-01f, 4.216965139e-01f, 3.651741147e-01f, 3.162277639e-01f, 2.738419771e-01f, 2.371373922e-01f, 2.053525001e-01f, 1.778279394e-01f, 1.539926529e-01f, 1.333521456e-01f, 1.154782027e-01f,
    1.000000015e-01f, 8.659642935e-02f, 7.498941571e-02f, 6.493816525e-02f, 5.623412877e-02f, 4.869675264e-02f, 4.216964915e-02f, 3.651741147e-02f, 3.162277862e-02f, 2.738419734e-02f, 2.371373586e-02f, 2.053524926e-02f, 1.778279431e-02f, 1.539926510e-02f, 1.333521493e-02f, 1.154781971e-02f,
    9.999999776e-03f, 8.659643121e-03f, 7.498942316e-03f, 6.493816618e-03f, 5.623413250e-03f, 4.869675264e-03f, 4.216964822e-03f, 3.651741426e-03f, 3.162277862e-03f, 2.738419687e-03f, 2.371373819e-03f, 2.053525066e-03f, 1.778279431e-03f, 1.539926627e-03f, 1.333521446e-03f, 1.154781901e-03f,
    1.000000047e-03f, 8.659643354e-04f, 7.498941850e-04f, 6.493816618e-04f, 5.623413017e-04f, 4.869675031e-04f, 4.216965463e-04f, 3.651741135e-04f, 3.162277862e-04f, 2.738419571e-04f, 2.371373848e-04f, 2.053525241e-04f, 1.778279402e-04f, 1.539926452e-04f, 1.333521504e-04f, 1.154782076e-04f};

__device__ __forceinline__ void sincos_acc(float af, float& sn, float& cs) {
    const double a = (double)af;
    const double k = __builtin_rint(a * 0.63661977236758134308);
    const double r = __builtin_fma(-k, 6.123233995736766036e-17, __builtin_fma(-k, 1.57079632679489655800, a));
    const double r2 = r * r;
    double s = -2.5052108385441718775e-8; s = s * r2 + 2.7557319223985890653e-6; s = s * r2 - 1.9841269841269841270e-4; s = s * r2 + 8.3333333333333333333e-3; s = s * r2 - 1.6666666666666666667e-1; s = s * r2 * r + r;
    double c = 2.0876756987868098979e-9; c = c * r2 - 2.7557319223985890653e-7; c = c * r2 + 2.4801587301587301587e-5; c = c * r2 - 1.3888888888888888889e-3; c = c * r2 + 4.1666666666666666667e-2; c = c * r2 - 0.5; c = c * r2 + 1.0;
    const int q = ((int)k) & 3;
    const double ss = (q == 0) ? s : (q == 1) ? c : (q == 2) ? -s : -c;
    const double cc = (q == 0) ? c : (q == 1) ? -s : (q == 2) ? -c : s;
    sn = (float)ss; cs = (float)cc;
}

__host__ __device__ __forceinline__ int tile_kind(int t) {
    if (t < 8) return 0; if (t < 16) return 1; if (t < 20) return 0; if (t == 20 || t == 21) return 1; if (t == 22) return 0; if (t == 23) return 1; if (t == 24) return 0; if (t == 25) return 1; if (t < 30) return 1; return 2;
}
__host__ __device__ __forceinline__ int tile_src_base(int t) { return t < 26 ? t * 256 : (t < 30 ? C_NZ + (t - 26) * 256 : C_NG); }
__host__ __device__ __forceinline__ int win_src_col(int np) {
    const int t = np >> 8, p = np & 255, kind = tile_kind(t), base = tile_src_base(t);
    if (kind == 1) return base + p;
    if (kind == 2) return p < 24 ? base + p : -1;
    const int bj = p >> 7, hl = (p >> 6) & 1, dd = p & 63;
    return base + hl * 128 + bj * 64 + dd;
}

__device__ __forceinline__ void p0_transpose_item(const float* W, int K, int N, bf16* WT, float* scr, int item, int lane, int nblk, int srcmode, const float* gk0, const float* gk1, int dstmode) {
    const int kb = item / nblk, nb = item % nblk, k0 = 64 * kb, n0 = 32 * nb;
    const int nq = lane & 7, kr = lane >> 3;
    const int src = srcmode == 0 ? win_src_col(n0 + 4 * nq) : n0 + 4 * nq;
    f32x4 v[8];
#pragma unroll
    for (int i = 0; i < 8; ++i) { const int k = k0 + 8 * i + kr; v[i] = src >= 0 ? *(const f32x4*)(W + (size_t)k * N + src) : (f32x4){0.f, 0.f, 0.f, 0.f}; }
#pragma unroll
    for (int i = 0; i < 8; ++i) { const int kk = 8 * i + kr; f32x4 t = v[i];
        if (gk0) { const int k = k0 + kk; t = t * (k < 1024 ? gk0[k] : gk1[k - 1024]); }
        float* s = scr + kk * 33 + 4 * nq; s[0] = t[0]; s[1] = t[1]; s[2] = t[2]; s[3] = t[3]; }
    asm volatile("s_waitcnt lgkmcnt(0)" ::: "memory");
    const int c = lane & 7;
#pragma unroll
    for (int j = 0; j < 4; ++j) { const int n = (lane >> 3) + 8 * j; const float* s = scr + (8 * c) * 33 + n;
        u32x4 o; o.x = pk2(s[0 * 33], s[1 * 33]); o.y = pk2(s[2 * 33], s[3 * 33]); o.z = pk2(s[4 * 33], s[5 * 33]); o.w = pk2(s[6 * 33], s[7 * 33]);
        const int np = n0 + n, k = k0 + 8 * c;
        const size_t d = dstmode == 0 ? (size_t)np * K + k : ((size_t)((np >> 4) * (K >> 5) + (k >> 5)) * 64 + ((k >> 3) & 3) * 16 + (np & 15)) * 8;
        *(u32x4*)(WT + d) = o; }
    asm volatile("s_waitcnt lgkmcnt(0)" ::: "memory");
}
__device__ __forceinline__ void rms_row_pair(const Bufs& Bf, int m, int lane) {
    bf16* H = Bf.b16(WS_H);
    const float* xr = Bf.x + (size_t)m * DM + lane * 8; f32x4 v[2][8]; float s[2] = {0.f, 0.f};
#pragma unroll
    for (int q = 0; q < 2; ++q)
#pragma unroll
        for (int j = 0; j < 4; ++j) { v[q][2 * j] = *(const f32x4*)(xr + q * DM + j * 512); v[q][2 * j + 1] = *(const f32x4*)(xr + q * DM + j * 512 + 4); }
#pragma unroll
    for (int q = 0; q < 2; ++q)
#pragma unroll
        for (int j = 0; j < 8; ++j) s[q] += (v[q][j].x * v[q][j].x + v[q][j].y * v[q][j].y) + (v[q][j].z * v[q][j].z + v[q][j].w * v[q][j].w);
#pragma unroll
    for (int q = 0; q < 2; ++q) { const float rstd = 1.0f / sqrtf(wave_sum(s[q]) * (1.f / DM) + EPS);
#pragma unroll
        for (int j = 0; j < 4; ++j) { const f32x4 g0 = *(const f32x4*)(Bf.g_norm + j * 512 + lane * 8), g1 = *(const f32x4*)(Bf.g_norm + j * 512 + lane * 8 + 4);
            const f32x4 a = v[q][2 * j] * rstd * g0, b = v[q][2 * j + 1] * rstd * g1;
            u32x4 o; o.x = pk2(a.x, a.y); o.y = pk2(a.z, a.w); o.z = pk2(b.x, b.y); o.w = pk2(b.z, b.w);
            *(u32x4*)(H + (size_t)(m + q) * DM + j * 512 + lane * 8) = o; } }
}
__device__ __forceinline__ void p0_prologue(const Bufs& Bf, int gw, int NGW, int lane, float* scr) {
    float* CB = Bf.f32(WS_CBIAS);
    for (int it = NGW - 1 - gw; it < 2 * 64; it += NGW) { const int kv = it >> 6, c = it & 63; const float* pe = kv ? Bf.pe_cv : Bf.pe_ck; const float* w1 = kv ? Bf.w_cv1 : Bf.w_ck1;
        float a0 = 0.f, a1 = 0.f, a2 = 0.f, a3 = 0.f;
#pragma unroll 8
        for (int k = 64 * c; k < 64 * c + 64; ++k) { const float p = pe[k]; const float* wr = w1 + (size_t)k * 256 + lane; a0 += p * wr[0]; a1 += p * wr[64]; a2 += p * wr[128]; a3 += p * wr[192]; }
        float* o = CB + (size_t)(kv * 64 + c) * 256 + lane; o[0] = a0; o[64] = a1; o[128] = a2; o[192] = a3; }
    for (int m = 2 * gw; m < M; m += 2 * NGW) rms_row_pair(Bf, m, lane);
    constexpr int I_IN = (2048 / 64) * (NPAD / 32), I_OUT = (2048 / 64) * (2048 / 32), I_C1 = (4096 / 64) * (256 / 32), I_C2 = (256 / 64) * (128 / 32);
    constexpr int NITEMS = I_IN + I_OUT + 2 * I_C1 + 2 * I_C2;
    for (int it = gw; it < NITEMS; it += NGW) {
        int r = it;
        if (r < I_IN) { p0_transpose_item(Bf.w_in, 2048, INC, Bf.b16(WS_WINT), scr, r, lane, NPAD / 32, 0, nullptr, nullptr, 0); continue; } r -= I_IN;
        if (r < I_OUT) { p0_transpose_item(Bf.w_out, 2048, 2048, Bf.b16(WS_WOUTT), scr, r, lane, 2048 / 32, 1, Bf.g_out_moba, Bf.g_out_nsa, 0); continue; } r -= I_OUT;
        if (r < I_C1) { p0_transpose_item(Bf.w_ck1, 4096, 256, Bf.b16(WS_WC1T), scr, r, lane, 256 / 32, 1, nullptr, nullptr, 1); continue; } r -= I_C1;
        if (r < I_C1) { p0_transpose_item(Bf.w_cv1, 4096, 256, Bf.b16(WS_WC1T) + 256 * 4096, scr, r, lane, 256 / 32, 1, nullptr, nullptr, 1); continue; } r -= I_C1;
        if (r < I_C2) { p0_transpose_item(Bf.w_ck2, 256, 128, Bf.b16(WS_WC2T), scr, r, lane, 128 / 32, 1, nullptr, nullptr, 0); continue; } r -= I_C2;
        p0_transpose_item(Bf.w_cv2, 256, 128, Bf.b16(WS_WC2T) + 128 * 256, scr, r, lane, 128 / 32, 1, nullptr, nullptr, 0);
    }
    float* COS = Bf.f32(WS_COS); float* SIN = Bf.f32(WS_SIN);
    for (int i = gw * 64 + lane; i < M * 64; i += NGW * 64) {
        const int row = i >> 6, f = i & 63; const float a = (float)Bf.pos[row] * INV_FREQ[f]; float sn, cs; sincos_acc(a, sn, cs); COS[i] = cs; SIN[i] = sn; }
}

namespace pg8 {
#define PG8_LAS __attribute__((address_space(3)))
typedef unsigned short bf16_t;
typedef short bf16x8 __attribute__((ext_vector_type(8)));
typedef float f32x4 __attribute__((ext_vector_type(4)));
typedef unsigned u32x4 __attribute__((ext_vector_type(4)));
constexpr int BM = 256, BK = 64, HALF = 128, HTB = HALF * BK * 2  , STAGE_BYTES = 8 * HTB, NXCD = 8, WGM = 8;

__host__ __device__ __forceinline__ int lds_byte(int r, int c) { const int st = (r >> 4) * 2 + (c >> 5), rr = r & 15, cc = c & 31, ob = rr * 64 + cc * 2; return st * 1024 + (ob ^ (((ob >> 9) & 1) << 5)); }
__host__ __device__ __forceinline__ void stage_rc(int b, int& R, int& C) { const int st = b / 1024, sb = b % 1024, swz = sb ^ (((sb >> 9) & 1) << 5); R = (st >> 1) * 16 + swz / 64; C = (st & 1) * 32 + (swz % 64) / 2; }
__host__ __device__ __forceinline__ int perm32(int rho) { const int n = rho >> 4, i = rho & 15; return 8 * (i >> 2) + 4 * n + (i & 3); }

struct Unit { int pm, pn; };
struct Gemm { const bf16_t* A; const bf16_t* Bt; int M, N, K; };

struct StaticOrder {
    int nM, nN, nwg, G, c;
    __host__ __device__ void init(int M, int N, int G_, int c_) { nM = M / BM; nN = N / BM; nwg = nM * nN; G = G_; c = c_; }
    __host__ __device__ bool next(int i, Unit& u) const {
        const long L = (long)i * G + c; if (L >= nwg) return false;
        int wgid = (int)L; { const int q = nwg / NXCD, r = nwg % NXCD, xcd = wgid % NXCD, off = wgid / NXCD; wgid = (xcd < r ? xcd * (q + 1) : r * (q + 1) + (xcd - r) * q) + off; }
        const int nig = WGM * nN, gid = wgid / nig, fm = gid * WGM, gsz = (nM - fm) < WGM ? (nM - fm) : WGM;
        u.pm = fm + ((wgid % nig) % gsz); u.pn = (wgid % nig) / gsz; return true;
    }
    __device__ __forceinline__ void a_ready(const Unit&) const {}
    __device__ __forceinline__ void done(const Unit&) const {}
};

__device__ __forceinline__ unsigned cvt_pk_bf16(float lo, float hi) { unsigned r; asm volatile("v_cvt_pk_bf16_f32 %0, %1, %2" : "=v"(r) : "v"(lo), "v"(hi)); return r; }

template <class Epi, class Sched, bool ALIGN_EPI = false, bool SP2 = false>
__device__ __forceinline__ void gemm_phase(PG8_LAS unsigned char* lds, const Gemm g, const Sched& S, const Epi& E) {
    const int tid = threadIdx.x, wid = __builtin_amdgcn_readfirstlane(tid >> 6), lane = tid & 63, wr = wid >> 2, wc = wid & 3, fr = lane & 15, fq = lane >> 4;
    const int K = g.K, nt = K / BK;
    unsigned voffA[2], voffB[2];
#pragma unroll
    for (int i = 0; i < 2; ++i) { int R, C; stage_rc(tid * 16 + i * 8192, R, C); const int Rb = Epi::PERM ? ((R & ~31) + perm32(R & 31)) : R;
        voffA[i] = (unsigned)(R * K + C) * 2u; voffB[i] = (unsigned)(Rb * K + C) * 2u; }
    const size_t kstep = (size_t)(BK * 2);
    const size_t hstep = (size_t)HALF * K * 2;
    const size_t tstep = 2 * hstep;
    const unsigned ldsw = (unsigned)wid * 1024u;
    const int aoff = lds_byte(wr * 64 + fr, fq * 8), boff = lds_byte(wc * 32 + fr, fq * 8);
#define PG8_SA(b, h) (((b) * 2 + (h)) * HTB)
#define PG8_SB(b, h) ((4 + (b) * 2 + (h)) * HTB)
#define PG8_STAGE(bufoff, gbase, voff) do { _Pragma("unroll") for (int _i = 0; _i < 2; ++_i) \
        __builtin_amdgcn_global_load_lds((const unsigned*)((const char*)(gbase) + (voff)[_i]), (PG8_LAS unsigned*)(lds + (bufoff) + ldsw + _i * 8192), 16, 0, 0); } while (0)
#define PG8_LDA(dst, b, h) do { _Pragma("unroll") for (int m = 0; m < 4; ++m) _Pragma("unroll") for (int k = 0; k < 2; ++k) dst[m][k] = *(const PG8_LAS bf16x8*)(lds + PG8_SA(b, h) + aoff + m * 2048 + k * 1024); } while (0)
#define PG8_LDB(dst, b, h) do { _Pragma("unroll") for (int n = 0; n < 2; ++n) _Pragma("unroll") for (int k = 0; k < 2; ++k) dst[n][k] = *(const PG8_LAS bf16x8*)(lds + PG8_SB(b, h) + boff + n * 2048 + k * 1024); } while (0)
#define PG8_MMA(ai, bj, At, Bt) do { __builtin_amdgcn_s_setprio(1); _Pragma("unroll") for (int m = 0; m < 4; ++m) _Pragma("unroll") for (int n = 0; n < 2; ++n) _Pragma("unroll") for (int k = 0; k < 2; ++k) \
        acc[ai][bj][m][n] = __builtin_amdgcn_mfma_f32_16x16x32_bf16(Bt[n][k], At[m][k], acc[ai][bj][m][n], 0, 0, 0); __builtin_amdgcn_s_setprio(0); } while (0)
#define PG8_WAIT_V(n) asm volatile("s_waitcnt vmcnt(" #n ")" ::: "memory")
#define PG8_WAIT_L(n) asm volatile("s_waitcnt lgkmcnt(" #n ")" ::: "memory")
#define PG8_BAR __builtin_amdgcn_s_barrier()
#define PG8_SCHED __builtin_amdgcn_sched_barrier(0)
    Unit cur, nxt; int ui = 0;
    if (!S.next(0, cur)) return;
    f32x4 acc[2][2][4][2];
#pragma unroll
    for (int a = 0; a < 2; ++a)
#pragma unroll
        for (int b = 0; b < 2; ++b)
#pragma unroll
            for (int m = 0; m < 4; ++m)
#pragma unroll
                for (int n = 0; n < 2; ++n) acc[a][b][m][n] = (f32x4){0.f, 0.f, 0.f, 0.f};
    bf16x8 At[4][2], B0[2][2], B1[2][2];
    const char* cA = (const char*)g.A + (size_t)cur.pm * tstep; const char* cB = (const char*)g.Bt + (size_t)cur.pn * tstep;
    S.a_ready(cur);
    if constexpr (SP2) {
        PG8_STAGE(PG8_SB(0, 0), cB, voffB); PG8_STAGE(PG8_SB(0, 1), cB + hstep, voffB); PG8_STAGE(PG8_SA(0, 0), cA, voffA); PG8_STAGE(PG8_SA(0, 1), cA + hstep, voffA);
        if (wr == 1) PG8_BAR;
        PG8_WAIT_V(2); PG8_BAR;
        PG8_STAGE(PG8_SB(1, 0), cB + kstep, voffB); PG8_STAGE(PG8_SA(1, 0), cA + kstep, voffA); PG8_STAGE(PG8_SB(1, 1), cB + hstep + kstep, voffB);
        PG8_WAIT_V(6); PG8_BAR;
    } else {
        PG8_STAGE(PG8_SB(0, 0), cB, voffB); PG8_STAGE(PG8_SA(0, 0), cA, voffA); PG8_STAGE(PG8_SB(0, 1), cB + hstep, voffB); PG8_STAGE(PG8_SA(0, 1), cA + hstep, voffA);
        if (wr == 1) PG8_BAR;
        PG8_WAIT_V(4); PG8_BAR;
        PG8_STAGE(PG8_SB(1, 0), cB + kstep, voffB); PG8_STAGE(PG8_SA(1, 0), cA + kstep, voffA); PG8_STAGE(PG8_SB(1, 1), cB + hstep + kstep, voffB);
        PG8_WAIT_V(6); PG8_BAR;
    }
    for (;;) {
        const bool has_next = S.next(ui + 1, nxt);
        const char* nA = has_next ? (const char*)g.A + (size_t)nxt.pm * tstep : cA; const char* nB = has_next ? (const char*)g.Bt + (size_t)nxt.pn * tstep : cB;
        for (int t = 0; t < nt; t += 2) {
            const bool last = (t == nt - 2);
            const char* a1 = cA + (size_t)(t + 1) * kstep;
            const char* a2 = last ? nA : cA + (size_t)(t + 2) * kstep; const char* b2 = last ? nB : cB + (size_t)(t + 2) * kstep;
            const char* a3 = a2 + kstep; const char* b3 = b2 + kstep;
            if (last && has_next) S.a_ready(nxt);
            if constexpr (SP2) {
            PG8_LDB(B0, 0, 0); PG8_LDB(B1, 0, 1); PG8_SCHED; PG8_LDA(At, 0, 0); PG8_STAGE(PG8_SA(1, 1), a1 + hstep, voffA);
            PG8_WAIT_V(8); PG8_WAIT_L(0); PG8_BAR; PG8_MMA(0, 0, At, B0); PG8_MMA(0, 1, At, B1); PG8_BAR; PG8_SCHED;
            PG8_LDA(At, 0, 1); PG8_STAGE(PG8_SB(0, 0), b2, voffB); PG8_STAGE(PG8_SB(0, 1), b2 + hstep, voffB); PG8_STAGE(PG8_SA(0, 0), a2, voffA);
            PG8_WAIT_V(8); PG8_WAIT_L(0); PG8_BAR; PG8_MMA(1, 0, At, B0); PG8_MMA(1, 1, At, B1); PG8_BAR; PG8_SCHED;
            PG8_LDB(B0, 1, 0); PG8_LDB(B1, 1, 1); PG8_SCHED; PG8_LDA(At, 1, 0); PG8_STAGE(PG8_SA(0, 1), a2 + hstep, voffA);
            PG8_WAIT_V(8); PG8_WAIT_L(0); PG8_BAR; PG8_MMA(0, 0, At, B0); PG8_MMA(0, 1, At, B1); PG8_BAR; PG8_SCHED;
            PG8_LDA(At, 1, 1); PG8_STAGE(PG8_SB(1, 0), b3, voffB); PG8_STAGE(PG8_SB(1, 1), b3 + hstep, voffB); PG8_STAGE(PG8_SA(1, 0), a3, voffA);
            PG8_WAIT_V(8); PG8_WAIT_L(0); PG8_BAR; PG8_MMA(1, 0, At, B0); PG8_MMA(1, 1, At, B1); PG8_BAR; PG8_SCHED;
            } else {
            PG8_LDB(B0, 0, 0); PG8_SCHED; PG8_LDA(At, 0, 0); PG8_STAGE(PG8_SA(1, 1), a1 + hstep, voffA);
            PG8_WAIT_L(8); PG8_BAR; PG8_WAIT_L(0); PG8_MMA(0, 0, At, B0); PG8_BAR; PG8_SCHED;
            PG8_LDB(B1, 0, 1); PG8_STAGE(PG8_SB(0, 0), b2, voffB);
            PG8_BAR; PG8_WAIT_L(0); PG8_MMA(0, 1, At, B1); PG8_BAR;
            PG8_LDA(At, 0, 1); PG8_STAGE(PG8_SA(0, 0), a2, voffA);
            PG8_BAR; PG8_WAIT_L(0); PG8_MMA(1, 0, At, B0); PG8_BAR; PG8_SCHED;
            PG8_STAGE(PG8_SB(0, 1), b2 + hstep, voffB);
            PG8_WAIT_V(6); PG8_BAR; PG8_MMA(1, 1, At, B1); PG8_BAR;
            PG8_LDB(B0, 1, 0); PG8_SCHED; PG8_LDA(At, 1, 0); PG8_STAGE(PG8_SA(0, 1), a2 + hstep, voffA);
            PG8_WAIT_L(8); PG8_BAR; PG8_WAIT_L(0); PG8_MMA(0, 0, At, B0); PG8_BAR; PG8_SCHED;
            PG8_LDB(B1, 1, 1); PG8_STAGE(PG8_SB(1, 0), b3, voffB);
            PG8_BAR; PG8_WAIT_L(0); PG8_MMA(0, 1, At, B1); PG8_BAR;
            PG8_LDA(At, 1, 1); PG8_STAGE(PG8_SA(1, 0), a3, voffA);
            PG8_BAR; PG8_WAIT_L(0); PG8_MMA(1, 0, At, B0); PG8_BAR; PG8_SCHED;
            PG8_STAGE(PG8_SB(1, 1), b3 + hstep, voffB);
            PG8_WAIT_V(6); PG8_BAR; PG8_MMA(1, 1, At, B1); PG8_BAR;
            }
        }
        if constexpr (ALIGN_EPI) { if (wr == 0) PG8_BAR; }
        if constexpr (!Epi::AFTER_DRAIN) { E(acc, cur, wr, wc, fr, fq); S.done(cur); }
        if (!has_next) break;
#pragma unroll
        for (int a = 0; a < 2; ++a)
#pragma unroll
            for (int b = 0; b < 2; ++b)
#pragma unroll
                for (int m = 0; m < 4; ++m)
#pragma unroll
                    for (int n = 0; n < 2; ++n) acc[a][b][m][n] = (f32x4){0.f, 0.f, 0.f, 0.f};
        cur = nxt; cA = nA; cB = nB; ++ui;
        if constexpr (ALIGN_EPI) { if (wr == 1) PG8_BAR; }
    }
    PG8_WAIT_V(0);
    if constexpr (!ALIGN_EPI) { if (wr == 0) PG8_BAR; }
    PG8_BAR;
    if constexpr (Epi::AFTER_DRAIN) { E.fused(acc, cur, wr, wc, fr, fq, lds, wid, lane); S.done(cur); }
#undef PG8_SA
#undef PG8_SB
#undef PG8_STAGE
#undef PG8_LDA
#undef PG8_LDB
#undef PG8_MMA
#undef PG8_WAIT_V
#undef PG8_WAIT_L
#undef PG8_BAR
#undef PG8_SCHED
}
}

struct EpiIn {
    static constexpr bool PERM = true, AFTER_DRAIN = false;
    Bufs bf;
    __device__ __forceinline__ void operator()(const f32x4 (&acc)[2][2][4][2], const pg8::Unit& u, int wr, int wc, int fr, int fq) const {
        const int t = u.pn, kind = tile_kind(t);
        const int b = u.pm >> 3, s0 = (u.pm & 7) * 256 + wr * 64 + fr, row0 = u.pm * 256 + wr * 64 + fr;
        if (kind == 0) {
            bf16* dst; bf16* raw = nullptr; int nh = 8, hb = 0;
            if (t < 4) { dst = bf.b16(WS_QM); hb = 2 * t; } else if (t < 8) { dst = bf.b16(WS_KM); hb = 2 * (t - 4); }
            else if (t < 20) { dst = bf.b16(WS_NQROT); raw = bf.b16(WS_NQRAW); hb = 2 * (t - 16); } else if (t == 22) { dst = bf.b16(WS_KS); nh = 2; } else { dst = bf.b16(WS_KW); nh = 2; }
            const int head = hb + (wc >> 1), dd0 = 32 * (wc & 1) + 8 * fq;
            const bool km = (t >= 4 && t < 8);
            const float* COS = bf.f32(WS_COS); const float* SIN = bf.f32(WS_SIN);
            f32x4 k1a = {0.f, 0.f, 0.f, 0.f}, k1b = k1a, k2a = k1a, k2b = k1a;
#pragma unroll
            for (int ai = 0; ai < 2; ++ai)
#pragma unroll
                for (int m = 0; m < 4; ++m) {
                    const int s = s0 + 128 * ai + 16 * m, row = row0 + 128 * ai + 16 * m;
                    const f32x4 c0 = *(const f32x4*)(COS + (size_t)row * 64 + dd0), c1 = *(const f32x4*)(COS + (size_t)row * 64 + dd0 + 4);
                    const f32x4 n0 = *(const f32x4*)(SIN + (size_t)row * 64 + dd0), n1 = *(const f32x4*)(SIN + (size_t)row * 64 + dd0 + 4);
                    const f32x4 x1a = acc[ai][0][m][0], x1b = acc[ai][0][m][1], x2a = acc[ai][1][m][0], x2b = acc[ai][1][m][1];
                    const f32x4 o1a = x1a * c0 - x2a * n0, o1b = x1b * c1 - x2b * n1, o2a = x2a * c0 + x1a * n0, o2b = x2b * c1 + x1b * n1;
                    const size_t o = ((size_t)(b * nh + head) * SEQ + s) * HD + dd0;
                    u32x4 w; w.x = pg8::cvt_pk_bf16(o1a[0], o1a[1]); w.y = pg8::cvt_pk_bf16(o1a[2], o1a[3]); w.z = pg8::cvt_pk_bf16(o1b[0], o1b[1]); w.w = pg8::cvt_pk_bf16(o1b[2], o1b[3]);
                    *(u32x4*)(dst + o) = w;
                    w.x = pg8::cvt_pk_bf16(o2a[0], o2a[1]); w.y = pg8::cvt_pk_bf16(o2a[2], o2a[3]); w.z = pg8::cvt_pk_bf16(o2b[0], o2b[1]); w.w = pg8::cvt_pk_bf16(o2b[2], o2b[3]);
                    *(u32x4*)(dst + o + 64) = w;
                    if (raw) {
                        w.x = pg8::cvt_pk_bf16(x1a[0], x1a[1]); w.y = pg8::cvt_pk_bf16(x1a[2], x1a[3]); w.z = pg8::cvt_pk_bf16(x1b[0], x1b[1]); w.w = pg8::cvt_pk_bf16(x1b[2], x1b[3]);
                        *(u32x4*)(raw + o) = w;
                        w.x = pg8::cvt_pk_bf16(x2a[0], x2a[1]); w.y = pg8::cvt_pk_bf16(x2a[2], x2a[3]); w.z = pg8::cvt_pk_bf16(x2b[0], x2b[1]); w.w = pg8::cvt_pk_bf16(x2b[2], x2b[3]);
                        *(u32x4*)(raw + o + 64) = w;
                    }
                    if (km) { k1a += o1a; k1b += o1b; k2a += o2a; k2b += o2b; }
                }
            if (km) {
#pragma unroll
                for (int off = 1; off < 16; off <<= 1)
#pragma unroll
                    for (int j = 0; j < 4; ++j) { k1a[j] += __shfl_xor(k1a[j], off); k1b[j] += __shfl_xor(k1b[j], off); k2a[j] += __shfl_xor(k2a[j], off); k2b[j] += __shfl_xor(k2b[j], off); }
                if (fr == 0) { float* kp = bf.f32(WS_KMS) + ((size_t)(b * 8 + head) * 8 + (u.pm & 7)) * 128 + dd0;
#pragma unroll
                    for (int j = 0; j < 4; ++j) { atomicAdd(kp + j, k1a[j]); atomicAdd(kp + 4 + j, k1b[j]); atomicAdd(kp + 64 + j, k2a[j]); atomicAdd(kp + 68 + j, k2b[j]); } }
            }
        } else if (kind == 1) {
            const bool isz = (t >= 12 && t < 16) || t >= 26;
            if (isz) {
                bf16* gz = bf.b16(WS_GZ) + (t < 16 ? (t - 12) * 256 : 1024 + (t - 26) * 256) + 32 * wc + 8 * fq;
#pragma unroll
                for (int ai = 0; ai < 2; ++ai)
#pragma unroll
                    for (int m = 0; m < 4; ++m) { const int row = row0 + 128 * ai + 16 * m;
#pragma unroll
                        for (int bj = 0; bj < 2; ++bj) { const f32x4 a = acc[ai][bj][m][0], c = acc[ai][bj][m][1];
                            u32x4 w; w.x = pg8::cvt_pk_bf16(silu_f(a[0]), silu_f(a[1])); w.y = pg8::cvt_pk_bf16(silu_f(a[2]), silu_f(a[3])); w.z = pg8::cvt_pk_bf16(silu_f(c[0]), silu_f(c[1])); w.w = pg8::cvt_pk_bf16(silu_f(c[2]), silu_f(c[3]));
                            *(u32x4*)(gz + (size_t)row * 2048 + 128 * bj) = w; } }
            } else {
                bf16* dst; int nh = 2, hb = 0;
                if (t < 12) { dst = bf.b16(WS_VM); nh = 8; hb = 2 * (t - 8); } else if (t == 20) dst = bf.b16(WS_KCIN); else if (t == 21) dst = bf.b16(WS_VCIN); else if (t == 23) dst = bf.b16(WS_VS); else dst = bf.b16(WS_VW);
#pragma unroll
                for (int ai = 0; ai < 2; ++ai)
#pragma unroll
                    for (int m = 0; m < 4; ++m) { const int s = s0 + 128 * ai + 16 * m;
#pragma unroll
                        for (int bj = 0; bj < 2; ++bj) { const f32x4 a = acc[ai][bj][m][0], c = acc[ai][bj][m][1];
                            u32x4 w; w.x = pg8::cvt_pk_bf16(a[0], a[1]); w.y = pg8::cvt_pk_bf16(a[2], a[3]); w.z = pg8::cvt_pk_bf16(c[0], c[1]); w.w = pg8::cvt_pk_bf16(c[2], c[3]);
                            *(u32x4*)(dst + ((size_t)(b * nh + hb + bj) * SEQ + s) * HD + 32 * wc + 8 * fq) = w; } }
            }
        } else {
            if (wc == 0 && fq < 3) { float* gp = bf.f32(WS_GATES) + 8 * fq;
#pragma unroll
                for (int ai = 0; ai < 2; ++ai)
#pragma unroll
                    for (int m = 0; m < 4; ++m) { const int row = row0 + 128 * ai + 16 * m; const f32x4 a = acc[ai][0][m][0], c = acc[ai][0][m][1];
                        *(f32x4*)(gp + (size_t)row * 24) = (f32x4){sigmoid_f(a[0]), sigmoid_f(a[1]), sigmoid_f(a[2]), sigmoid_f(a[3])};
                        *(f32x4*)(gp + (size_t)row * 24 + 4) = (f32x4){sigmoid_f(c[0]), sigmoid_f(c[1]), sigmoid_f(c[2]), sigmoid_f(c[3])}; } }
        }
    }
};
struct EpiOut {
    static constexpr bool PERM = false, AFTER_DRAIN = false;
    const float* x; float* out;
    __device__ __forceinline__ void operator()(const f32x4 (&acc)[2][2][4][2], const pg8::Unit& u, int wr, int wc, int fr, int fq) const {
        const int row0 = u.pm * 256 + wr * 64 + fr, col0 = u.pn * 256 + wc * 32 + 4 * fq;
#pragma unroll
        for (int ai = 0; ai < 2; ++ai)
#pragma unroll
            for (int m = 0; m < 4; ++m) { const size_t off = (size_t)(row0 + 128 * ai + 16 * m) * DM + col0;
#pragma unroll
                for (int bj = 0; bj < 2; ++bj)
#pragma unroll
                    for (int n = 0; n < 2; ++n) { const size_t o = off + bj * 128 + n * 16; *(f32x4*)(out + o) = *(const f32x4*)(x + o) + acc[ai][bj][m][n]; } }
    }
};

namespace att {
constexpr int SHM_K = 16384, SHM_V = 16384;
constexpr int L_V = 0, L_K = 32768, L_WS = 65536, L_SEL = 67584, L_ITEM = 67840, L_IMP = 68096, L_SCORE = L_IMP + 32768, L_ACC = L_IMP;
constexpr float THR = 8.f;
constexpr float C2 = 1.4426950408889634f * SCALE;
constexpr unsigned WBIG = 0x7fffffffu;
#define KSWZ(row, colB) ((row) * 256 + ((colB) ^ (((row) & 7) << 4)))
#define SBAR() __builtin_amdgcn_sched_barrier(0)
__device__ __forceinline__ int v_st(int k, int c) { const int kk = (k & ~0xC) | ((k & 4) << 1) | ((k & 8) >> 1); return ((kk >> 3) * 4 + (c >> 5)) * 512 + ((kk & 7) * 32 + (c & 31)) * 2; }
__device__ __forceinline__ int v_rd_base(int lane) { return ((lane & 3) << 3) | (((lane >> 2) & 3) << 6) | (((lane >> 4) & 1) << 5) | (((lane >> 5) & 1) << 8); }
constexpr int v_rd_off(int d0, int ks, int half) { return d0 * 512 + ks * 4096 + half * 2048; }
__device__ __forceinline__ int crow(int r, int hi) { return (r & 3) + 8 * (r >> 2) + 4 * hi; }
__device__ __forceinline__ unsigned cvtpk(float lo, float hi) { unsigned r; asm volatile("v_cvt_pk_bf16_f32 %0, %1, %2" : "=v"(r) : "v"(lo), "v"(hi)); return r; }
typedef short s16x4 __attribute__((ext_vector_type(4)));
__device__ __forceinline__ int opaque_tid() { int t = threadIdx.x; asm volatile("" : "+v"(t)); return t; }

__device__ __forceinline__ void mask_tile(f32x16& p0, f32x16& p1, int dq, unsigned W) {
    const float NEG = -__builtin_inff();
#pragma unroll
    for (int r = 0; r < 16; ++r) { const int c = (r & 3) + 8 * (r >> 2);
        if ((unsigned)(dq - c) >= W) p0[r] = NEG;
        if ((unsigned)(dq - c - 32) >= W) p1[r] = NEG; }
}
#define PK4(P, B_, OUT) do { unsigned a0 = cvtpk(P[B_+0], P[B_+1]), a1 = cvtpk(P[B_+2], P[B_+3]); unsigned b0 = cvtpk(P[B_+4], P[B_+5]), b1 = cvtpk(P[B_+6], P[B_+7]); \
        auto r0 = __builtin_amdgcn_permlane32_swap(a0, b0, false, false); auto r1 = __builtin_amdgcn_permlane32_swap(a1, b1, false, false); \
        u32x4 w = {r0[0], r1[0], r0[1], r1[1]}; OUT = *reinterpret_cast<bf16x8*>(&w); } while (0)
__device__ __forceinline__ float softmax_tile(f32x16& p0, f32x16& p1, float& m_reg, float& l_reg, bool rowok, bf16x8& pa0, bf16x8& pa1, bf16x8& pa2, bf16x8& pa3) {
    float pmax = p0[0];
#pragma unroll
    for (int r = 1; r < 16; ++r) pmax = fmaxf(pmax, p0[r]);
#pragma unroll
    for (int r = 0; r < 16; ++r) pmax = fmaxf(pmax, p1[r]);
    { auto rr = __builtin_amdgcn_permlane32_swap(__float_as_uint(pmax), __float_as_uint(pmax), false, false); pmax = fmaxf(__uint_as_float(rr[0]), __uint_as_float(rr[1])); }
    if (!rowok) pmax = -__builtin_inff();
    float mn, alpha;
    if (__builtin_expect(__all((pmax - m_reg) * SCALE <= THR), 1)) { mn = m_reg; alpha = 1.f; }
    else { mn = fmaxf(m_reg, pmax); alpha = __builtin_amdgcn_exp2f((m_reg - mn) * C2); m_reg = mn; }
    const float mnL = rowok ? -mn * C2 : -__builtin_inff();
#pragma unroll
    for (int r = 0; r < 16; ++r) { p0[r] = __builtin_amdgcn_exp2f(fmaf(p0[r], C2, mnL)); p1[r] = __builtin_amdgcn_exp2f(fmaf(p1[r], C2, mnL)); }
    float ps = 0.f;
#pragma unroll
    for (int r = 0; r < 16; ++r) ps += p0[r];
#pragma unroll
    for (int r = 0; r < 16; ++r) ps += p1[r];
    { auto rr = __builtin_amdgcn_permlane32_swap(__float_as_uint(ps), __float_as_uint(ps), false, false); ps = __uint_as_float(rr[0]) + __uint_as_float(rr[1]); }
    l_reg = l_reg * alpha + ps;
    PK4(p0, 0, pa0); PK4(p0, 8, pa1); PK4(p1, 0, pa2); PK4(p1, 8, pa3);
    return alpha;
}
__device__ __forceinline__ void qkt(f32x16& p0, f32x16& p1, const char* Kb, int r32, int hi, const bf16x8 (&qr)[8]) {
    p0 = f32x16{}; p1 = f32x16{};
    const char* kb[4];
#pragma unroll
    for (int dd = 0; dd < 4; ++dd) kb[dd] = Kb + KSWZ(r32, (dd * 16 + hi * 8) * 2);
#pragma unroll
    for (int d0 = 0; d0 < 8; ++d0) { const char* a = kb[d0 & 3] + (d0 >> 2) * 128;
        const bf16x8 b0 = *reinterpret_cast<const bf16x8*>(a);
        const bf16x8 b1 = *reinterpret_cast<const bf16x8*>(a + 32 * 256);
        p0 = __builtin_amdgcn_mfma_f32_32x32x16_bf16(b0, qr[d0], p0, 0, 0, 0);
        p1 = __builtin_amdgcn_mfma_f32_32x32x16_bf16(b1, qr[d0], p1, 0, 0, 0); }
}
__device__ __forceinline__ void qkt_half(f32x16& p0, const char* Kb, int r32, int hi, const bf16x8 (&qr)[8]) {
    p0 = f32x16{};
    const char* kb[4];
#pragma unroll
    for (int dd = 0; dd < 4; ++dd) kb[dd] = Kb + KSWZ(r32, (dd * 16 + hi * 8) * 2);
#pragma unroll
    for (int d0 = 0; d0 < 8; ++d0) { const char* a = kb[d0 & 3] + (d0 >> 2) * 128;
        const bf16x8 b0 = *reinterpret_cast<const bf16x8*>(a);
        p0 = __builtin_amdgcn_mfma_f32_32x32x16_bf16(b0, qr[d0], p0, 0, 0, 0); }
}
__device__ __forceinline__ void pv_tile(f32x16 (&o)[4], int vb0, bf16x8 pa0, bf16x8 pa1, bf16x8 pa2, bf16x8 pa3) {
#define TRRD(dst, off) asm volatile("ds_read_b64_tr_b16 %0, %1 offset:%2" : "=&v"(dst) : "v"(vb0), "i"(off) : "memory")
#define PV_D0(d0) do { s16x4 l0, l1, l2, l3, h0, h1, h2, h3; constexpr int b_ = v_rd_off(d0, 0, 0); \
        TRRD(l0, b_); TRRD(h0, b_ + 2048); TRRD(l1, b_ + 4096); TRRD(h1, b_ + 6144); TRRD(l2, b_ + 8192); TRRD(h2, b_ + 10240); TRRD(l3, b_ + 12288); TRRD(h3, b_ + 14336); \
        asm volatile("s_waitcnt lgkmcnt(0)" ::: "memory"); SBAR(); \
        o[d0] = __builtin_amdgcn_mfma_f32_32x32x16_bf16(pa0, (bf16x8){l0[0], l0[1], l0[2], l0[3], h0[0], h0[1], h0[2], h0[3]}, o[d0], 0, 0, 0); \
        o[d0] = __builtin_amdgcn_mfma_f32_32x32x16_bf16(pa1, (bf16x8){l1[0], l1[1], l1[2], l1[3], h1[0], h1[1], h1[2], h1[3]}, o[d0], 0, 0, 0); \
        o[d0] = __builtin_amdgcn_mfma_f32_32x32x16_bf16(pa2, (bf16x8){l2[0], l2[1], l2[2], l2[3], h2[0], h2[1], h2[2], h2[3]}, o[d0], 0, 0, 0); \
        o[d0] = __builtin_amdgcn_mfma_f32_32x32x16_bf16(pa3, (bf16x8){l3[0], l3[1], l3[2], l3[3], h3[0], h3[1], h3[2], h3[3]}, o[d0], 0, 0, 0); } while (0)
    PV_D0(0); PV_D0(1); PV_D0(2); PV_D0(3);
#undef PV_D0
#undef TRRD
}
struct Stage { bf16x8 k0, k1, v0, v1; };
__device__ __forceinline__ void stage_load(Stage& S, const bf16* K, const bf16* V, int krow, int sr, int sc) {
    S.v0 = *(const bf16x8*)(V + (size_t)(krow + sr) * HD + sc); S.v1 = *(const bf16x8*)(V + (size_t)(krow + 32 + sr) * HD + sc);
    S.k0 = *(const bf16x8*)(K + (size_t)(krow + sr) * HD + sc); S.k1 = *(const bf16x8*)(K + (size_t)(krow + 32 + sr) * HD + sc);
}
__device__ __forceinline__ void stage_write(const Stage& S, char* Kb, char* Vb, int kws, int vst0, int vst1) {
    *(bf16x8*)(Kb + kws) = S.k0; *(bf16x8*)(Kb + kws + 32 * 256) = S.k1; *(bf16x8*)(Vb + vst0) = S.v0; *(bf16x8*)(Vb + vst1) = S.v1;
}
#define RESC(a) do { if (__any((a) < 1.f)) { if (hi == 0) al_l[r32] = (a); asm volatile("s_waitcnt lgkmcnt(0)" ::: "memory"); \
        _Pragma("unroll") for (int d_ = 0; d_ < 4; ++d_) _Pragma("unroll") for (int r = 0; r < 16; ++r) o[d_][r] *= al_l[crow(r, hi)]; } } while (0)

template <int MODE>
__device__ __forceinline__ void attn_pass(char* lds, const bf16x8 (&qr)[8], const bf16* K, const bf16* V, int t_lo, int t_hi, int posq, int qlo, unsigned sel, int own, f32x16 (&o)[4], float& l_out) {
    const int tid = opaque_tid(), lane = tid & 63, r32 = lane & 31, hi = lane >> 5, wid = __builtin_amdgcn_readfirstlane(tid >> 6);
    char* V_lds = lds + L_V; char* K_lds = lds + L_K;
    float* al_l = (float*)(lds + L_WS) + wid * 64 + 32;
    const int sr = tid >> 4, sc = (tid & 15) * 8, vst0 = v_st(sr, sc), vst1 = v_st(32 + sr, sc), kws = KSWZ(sr, sc * 2);
    const int vbase = (int)(uintptr_t)V_lds + v_rd_base(lane);
    float m_reg = -1e30f, l_reg = 0.f;
#pragma unroll
    for (int d = 0; d < 4; ++d) o[d] = f32x16{};
    Stage S;
    stage_load(S, K, V, t_lo * 64, sr, sc);
    stage_write(S, K_lds, V_lds, kws, vst0, vst1);
    __syncthreads();
    const int NT = t_hi - t_lo;
    for (int i = 0; i < NT; ++i) {
        const int t = t_lo + i, cur = i & 1, kb = t * 64;
        if (i + 1 < NT) stage_load(S, K, V, kb + 64, sr, sc);
        bool rowok = true, elem = false, act = true; unsigned W = WBIG;
        if (MODE == 0) { const int j = t >> 2; if (j < own) { rowok = (sel >> j) & 1u; act = __any(rowok); } else { elem = kb + 63 > qlo; act = kb <= qlo + 31; } }
        if (MODE == 2) { if (t < own) { rowok = (sel >> t) & 1u; act = __any(rowok); } else elem = true; }
        if (MODE == 3) { W = 512u; elem = (t == own) || (t == own - 8); }
        if (act) {
            f32x16 p0, p1;
            qkt(p0, p1, K_lds + cur * SHM_K, r32, hi, qr);
            if (elem) mask_tile(p0, p1, posq - kb - 4 * hi, W);
            bf16x8 pa0, pa1, pa2, pa3;
            const float alpha = softmax_tile(p0, p1, m_reg, l_reg, rowok, pa0, pa1, pa2, pa3);
            RESC(alpha);
            pv_tile(o, vbase + cur * SHM_V, pa0, pa1, pa2, pa3);
        }
        if (i + 1 < NT) stage_write(S, K_lds + (cur ^ 1) * SHM_K, V_lds + (cur ^ 1) * SHM_V, kws, vst0, vst1);
        __syncthreads();
    }
    l_out = l_reg;
}
#define ROW_RLI(lval) do { if (hi == 0) li_l[r32] = (lval); asm volatile("s_waitcnt lgkmcnt(0)" ::: "memory"); \
        _Pragma("unroll") for (int r = 0; r < 16; ++r) { const float lv_ = li_l[crow(r, hi)]; rli[r] = lv_ > 0.f ? __builtin_amdgcn_rcpf(lv_) : 0.f; } asm volatile("s_waitcnt lgkmcnt(0)" ::: "memory"); } while (0)

__device__ __forceinline__ void moba_item(const Bufs& bf, char* lds, int bh, int own) {
    const int tid = opaque_tid(), lane = tid & 63, r32 = lane & 31, hi = lane >> 5, wid = __builtin_amdgcn_readfirstlane(tid >> 6);
    const int b = bh >> 3, h = bh & 7, qlo = own * 256 + wid * 32, posq = qlo + r32;
    float* li_l = (float*)(lds + L_WS) + wid * 64;
    const bf16* Q = bf.b16(WS_QM) + ((size_t)bh * SEQ + posq) * HD; const bf16* K = bf.b16(WS_KM) + (size_t)bh * SEQ * HD; const bf16* V = bf.b16(WS_VM) + (size_t)bh * SEQ * HD;
    bf16x8 qr[8];
#pragma unroll
    for (int d0 = 0; d0 < 8; ++d0) qr[d0] = *(const bf16x8*)(Q + d0 * 16 + hi * 8);
    unsigned sel = 0u;
    if (own > 0) {
        char* K_lds = lds + L_K;
        if (tid < 256) {
            const int row = tid >> 4, c8 = (tid & 15) * 8; const float* src = bf.f32(WS_KMS) + ((size_t)bh * 8 + (row & 7)) * 128 + c8;
            const f32x4 a = *(const f32x4*)src, c = *(const f32x4*)(src + 4); float v[8] = {a[0], a[1], a[2], a[3], c[0], c[1], c[2], c[3]};
            if (row >= 8) {
#pragma unroll
                for (int j = 0; j < 8; ++j) v[j] = v[j] - bf2f(f2bf(v[j])); }
            u32x4 w; w.x = pk2(v[0], v[1]); w.y = pk2(v[2], v[3]); w.z = pk2(v[4], v[5]); w.w = pk2(v[6], v[7]);
            *(u32x4*)(K_lds + KSWZ(row, c8 * 2)) = w;
        }
        __syncthreads();
        f32x16 gp; qkt_half(gp, K_lds, r32, hi, qr);
        float gm[4], go[4], g[8];
#pragma unroll
        for (int j = 0; j < 4; ++j) gm[j] = gp[j] + gp[4 + j];
#pragma unroll
        for (int j = 0; j < 4; ++j) go[j] = __shfl_xor(gm[j], 32);
#pragma unroll
        for (int j = 0; j < 4; ++j) { g[j] = hi ? go[j] : gm[j]; g[4 + j] = hi ? gm[j] : go[j]; }
#pragma unroll
        for (int j = 0; j < 8; ++j) { int rank = 0;
#pragma unroll
            for (int k = 0; k < 8; ++k) if (k != j) rank += (k < own && (g[k] > g[j] || (g[k] == g[j] && k < j))) ? 1 : 0;
            if (j < own && rank < 3) sel |= 1u << j; }
        __syncthreads();
    }
    f32x16 o[4]; float l;
    attn_pass<0>(lds, qr, K, V, 0, 4 * own + 4, posq, qlo, sel, own, o, l);
    float rli[16]; ROW_RLI(l);
    const size_t tok0 = (size_t)b * SEQ + own * 256 + wid * 32;
    const bf16* GZ = bf.b16(WS_GZ); bf16* T = bf.b16(WS_T);
#pragma unroll
    for (int r = 0; r < 16; ++r) { const size_t base = (tok0 + crow(r, hi)) * 2048 + h * 128 + r32;
#pragma unroll
        for (int d0 = 0; d0 < 4; ++d0) { const float v = o[d0][r] * rli[r]; const float vn = __shfl_xor(v, 1);
            if ((r32 & 1) == 0) { const unsigned gz = *(const unsigned*)(GZ + base + d0 * 32); *(unsigned*)(T + base + d0 * 32) = cvtpk(v * bf2f(gz & 0xffffu), vn * bf2f(gz >> 16)); } } }
}

__device__ __forceinline__ void nsa_item(const Bufs& bf, char* lds, int bg, int own) {
    const int tid = opaque_tid(), lane = tid & 63, r32 = lane & 31, hi = lane >> 5, wid = __builtin_amdgcn_readfirstlane(tid >> 6);
    const int b = bg >> 1, g = bg & 1, headr = wid >> 1, head = 4 * g + headr, qq = 32 * (wid & 1) + r32, qlo = 64 * own + 32 * (wid & 1), posq = qlo + r32;
    char* V_lds = lds + L_V; char* K_lds = lds + L_K;
    float* li_l = (float*)(lds + L_WS) + wid * 64;
    float* impb = (float*)(lds + L_IMP); float* scoreb = (float*)(lds + L_SCORE); unsigned* selb = (unsigned*)(lds + L_SEL);
    const int sr = tid >> 4, sc = (tid & 15) * 8, vst0 = v_st(sr, sc), vst1 = v_st(32 + sr, sc), kws = KSWZ(sr, sc * 2);
    const int vbase = (int)(uintptr_t)V_lds + v_rd_base(lane);
    const size_t tok0 = (size_t)b * SEQ + qlo;
    const float* GT = bf.f32(WS_GATES) + (g * 4 + headr) * 3;
    bf16x8 qr[8]; f32x16 o[4]; float rli[16];
    {
        const bf16* KC = bf.b16(WS_KC) + (size_t)bg * 128 * HD; const bf16* VC = bf.b16(WS_VC) + (size_t)bg * 128 * HD;
        const bf16* Q = bf.b16(WS_NQRAW) + ((size_t)(b * 8 + head) * SEQ + posq) * HD;
#pragma unroll
        for (int d0 = 0; d0 < 8; ++d0) qr[d0] = *(const bf16x8*)(Q + d0 * 16 + hi * 8);
        { Stage S0, S1; stage_load(S0, KC, VC, 0, sr, sc); stage_load(S1, KC, VC, 64, sr, sc);
          stage_write(S0, K_lds, V_lds, kws, vst0, vst1); stage_write(S1, K_lds + SHM_K, V_lds + SHM_V, kws, vst0, vst1); }
        __syncthreads();
        f32x16 pA0, pA1, pB0, pB1;
        qkt(pA0, pA1, K_lds, r32, hi, qr); qkt(pB0, pB1, K_lds + SHM_K, r32, hi, qr);
        const int nmax = (posq - 31) >> 4;
        mask_tile(pA0, pA1, nmax - 4 * hi, WBIG); mask_tile(pB0, pB1, nmax - 64 - 4 * hi, WBIG);
        float pmax = pA0[0];
#pragma unroll
        for (int r = 0; r < 16; ++r) pmax = fmaxf(fmaxf(pmax, pA0[r]), fmaxf(pA1[r], fmaxf(pB0[r], pB1[r])));
        { auto rr = __builtin_amdgcn_permlane32_swap(__float_as_uint(pmax), __float_as_uint(pmax), false, false); pmax = fmaxf(__uint_as_float(rr[0]), __uint_as_float(rr[1])); }
        const float mnL = (pmax == -__builtin_inff()) ? 0.f : -pmax * C2;
        float ps = 0.f;
#pragma unroll
        for (int r = 0; r < 16; ++r) { pA0[r] = __builtin_amdgcn_exp2f(fmaf(pA0[r], C2, mnL)); pA1[r] = __builtin_amdgcn_exp2f(fmaf(pA1[r], C2, mnL));
            pB0[r] = __builtin_amdgcn_exp2f(fmaf(pB0[r], C2, mnL)); pB1[r] = __builtin_amdgcn_exp2f(fmaf(pB1[r], C2, mnL)); ps += (pA0[r] + pA1[r]) + (pB0[r] + pB1[r]); }
        { auto rr = __builtin_amdgcn_permlane32_swap(__float_as_uint(ps), __float_as_uint(ps), false, false); ps = __uint_as_float(rr[0]) + __uint_as_float(rr[1]); }
        const float rl = ps > 0.f ? 1.f / ps : 0.f;
        {
            float G[16], L[16], Lo[16];
#pragma unroll
            for (int q4 = 0; q4 < 4; ++q4) {
                G[q4] = ((pA0[4 * q4] + pA0[4 * q4 + 1]) + (pA0[4 * q4 + 2] + pA0[4 * q4 + 3])) * rl; L[q4] = pA0[4 * q4 + 3] * rl;
                G[4 + q4] = ((pA1[4 * q4] + pA1[4 * q4 + 1]) + (pA1[4 * q4 + 2] + pA1[4 * q4 + 3])) * rl; L[4 + q4] = pA1[4 * q4 + 3] * rl;
                G[8 + q4] = ((pB0[4 * q4] + pB0[4 * q4 + 1]) + (pB0[4 * q4 + 2] + pB0[4 * q4 + 3])) * rl; L[8 + q4] = pB0[4 * q4 + 3] * rl;
                G[12 + q4] = ((pB1[4 * q4] + pB1[4 * q4 + 1]) + (pB1[4 * q4 + 2] + pB1[4 * q4 + 3])) * rl; L[12 + q4] = pB1[4 * q4 + 3] * rl; }
#pragma unroll
            for (int i = 0; i < 16; ++i) Lo[i] = __shfl_xor(L[i], 32);
            float* ib = impb + ((size_t)headr * 64 + qq) * 32 + hi;
#pragma unroll
            for (int i = 0; i < 16; ++i) { const float prev = hi ? Lo[i] : (i > 0 ? Lo[i > 0 ? i - 1 : 0] : 0.f); ib[2 * i] = G[i] + prev; }
        }
        bf16x8 pa0, pa1, pa2, pa3, pb0, pb1, pb2, pb3;
        PK4(pA0, 0, pa0); PK4(pA0, 8, pa1); PK4(pA1, 0, pa2); PK4(pA1, 8, pa3);
        PK4(pB0, 0, pb0); PK4(pB0, 8, pb1); PK4(pB1, 0, pb2); PK4(pB1, 8, pb3);
#pragma unroll
        for (int d = 0; d < 4; ++d) o[d] = f32x16{};
        pv_tile(o, vbase, pa0, pa1, pa2, pa3); pv_tile(o, vbase + SHM_V, pb0, pb1, pb2, pb3);
        if (hi == 0) li_l[r32] = rl; asm volatile("s_waitcnt lgkmcnt(0)" ::: "memory");
#pragma unroll
        for (int r = 0; r < 16; ++r) { const int rw = crow(r, hi); const float f = li_l[rw] * GT[(tok0 + rw) * 24 + 0];
#pragma unroll
            for (int d0 = 0; d0 < 4; ++d0) o[d0][r] *= f; }
        asm volatile("s_waitcnt lgkmcnt(0)" ::: "memory");
    }
    __syncthreads();
    {
        const int qs = tid >> 3, jg = tid & 7; float s4[4];
#pragma unroll
        for (int jj = 0; jj < 4; ++jj) { const int j = 4 * jg + jj;
            float s = ((impb[(0 * 64 + qs) * 32 + j] + impb[(1 * 64 + qs) * 32 + j]) + impb[(2 * 64 + qs) * 32 + j]) + impb[(3 * 64 + qs) * 32 + j];
            if (j > own) s = -__builtin_inff(); else if (j == 0 || j == own || j == own - 1) s = __builtin_inff();
            s4[jj] = s; scoreb[qs * 32 + j] = s; }
        __syncthreads();
        unsigned bits = 0u;
#pragma unroll
        for (int jj = 0; jj < 4; ++jj) { const int j = 4 * jg + jj; const float s = s4[jj]; int rank = 0;
            for (int k = 0; k < 32; ++k) { const float sk = scoreb[qs * 32 + k]; rank += (sk > s || (sk == s && k < j)) ? 1 : 0; }
            if (rank < 8 && s > -__builtin_inff()) bits |= 1u << j; }
        bits |= __shfl_xor(bits, 1); bits |= __shfl_xor(bits, 2); bits |= __shfl_xor(bits, 4);
        if (jg == 0) selb[qs] = bits;
        __syncthreads();
    }
    const unsigned sel = selb[qq];
    char* accp = lds + L_ACC + tid * 16;
#pragma unroll
    for (int q = 0; q < 8; ++q) { const int d0 = q >> 1, r0 = 8 * (q & 1);
        u32x4 w; w.x = cvtpk(o[d0][r0], o[d0][r0 + 1]); w.y = cvtpk(o[d0][r0 + 2], o[d0][r0 + 3]); w.z = cvtpk(o[d0][r0 + 4], o[d0][r0 + 5]); w.w = cvtpk(o[d0][r0 + 6], o[d0][r0 + 7]);
        *(u32x4*)(accp + q * 8192) = w; }
    {
        const bf16* Q = bf.b16(WS_NQROT) + ((size_t)(b * 8 + head) * SEQ + posq) * HD;
#pragma unroll
        for (int d0 = 0; d0 < 8; ++d0) qr[d0] = *(const bf16x8*)(Q + d0 * 16 + hi * 8);
        float l;
        attn_pass<2>(lds, qr, bf.b16(WS_KS) + (size_t)bg * SEQ * HD, bf.b16(WS_VS) + (size_t)bg * SEQ * HD, 0, own + 1, posq, qlo, sel, own, o, l);
        ROW_RLI(l);
#pragma unroll
        for (int r = 0; r < 16; ++r) rli[r] *= GT[(tok0 + crow(r, hi)) * 24 + 1];
#pragma unroll
        for (int q = 0; q < 8; ++q) { const int d0 = q >> 1, r0 = 8 * (q & 1);
            const u32x4 a = *(const u32x4*)(accp + q * 8192); const unsigned aw[4] = {a.x, a.y, a.z, a.w}; unsigned ow[4];
#pragma unroll
            for (int k = 0; k < 4; ++k) ow[k] = cvtpk(bf2f(aw[k] & 0xffffu) + o[d0][r0 + 2 * k] * rli[r0 + 2 * k], bf2f(aw[k] >> 16) + o[d0][r0 + 2 * k + 1] * rli[r0 + 2 * k + 1]);
            *(u32x4*)(accp + q * 8192) = (u32x4){ow[0], ow[1], ow[2], ow[3]}; }
    }
    {
        float l;
        attn_pass<3>(lds, qr, bf.b16(WS_KW) + (size_t)bg * SEQ * HD, bf.b16(WS_VW) + (size_t)bg * SEQ * HD, own > 8 ? own - 8 : 0, own + 1, posq, qlo, 0u, own, o, l);
        ROW_RLI(l);
        const bf16* GZ = bf.b16(WS_GZ); bf16* T = bf.b16(WS_T);
#pragma unroll
        for (int r = 0; r < 16; ++r) rli[r] *= GT[(tok0 + crow(r, hi)) * 24 + 2];
#pragma unroll
        for (int q = 0; q < 8; ++q) { const int d0 = q >> 1, r0 = 8 * (q & 1);
            const u32x4 a = *(const u32x4*)(accp + q * 8192); const unsigned aw[4] = {a.x, a.y, a.z, a.w};
#pragma unroll
            for (int k = 0; k < 8; ++k) { const int r = r0 + k; const float av = (k & 1) ? bf2f(aw[k >> 1] >> 16) : bf2f(aw[k >> 1] & 0xffffu);
                const float v = av + o[d0][r] * rli[r]; const float vn = __shfl_xor(v, 1);
                const size_t base = (tok0 + crow(r, hi)) * 2048 + 1024 + head * 128 + d0 * 32 + r32;
                if ((r32 & 1) == 0) { const unsigned gz = *(const unsigned*)(GZ + base); *(unsigned*)(T + base) = cvtpk(v * bf2f(gz & 0xffffu), vn * bf2f(gz >> 16)); } } }
    }
}

struct ItemTable { unsigned short v[1024]; };
constexpr int moba_cost(int own) { return 4 * (own + 1) + 1; }
constexpr int nsa_cost(int own) { return 3 + (own + 1) + ((own + 1) < 9 ? (own + 1) : 9); }
constexpr ItemTable make_items() {
    ItemTable t{}; int n = 0;
    for (int c = 64; c >= 0; --c) {
        for (int own = 0; own < 8; ++own) if (moba_cost(own) == c) for (int bh = 0; bh < 64; ++bh) t.v[n++] = (unsigned short)((bh << 3) | own);
        for (int own = 0; own < 32; ++own) if (nsa_cost(own) == c) for (int bg = 0; bg < 16; ++bg) t.v[n++] = (unsigned short)(0x8000 | (bg << 5) | own);
    }
    return t;
}
__device__ const ItemTable ITEMS = make_items();

__device__ __forceinline__ void attn_phase(const Bufs& bf, char* lds, int ctr_idx = 64) {
    const int tid = threadIdx.x;
    volatile int* itemw = (volatile int*)(lds + L_ITEM);
    unsigned* ctr = (unsigned*)(bf.ws + WS_CTL) + ctr_idx;
    for (;;) {
        if (tid == 0) *itemw = (int)atomicAdd(ctr, 1u);
        __syncthreads();
        const int it = __builtin_amdgcn_readfirstlane(*itemw);
        __syncthreads();
        if (it >= 1024) break;
        const unsigned e = ITEMS.v[it];
        if (e & 0x8000u) nsa_item(bf, lds, (int)((e >> 5) & 15u), (int)(e & 31u)); else moba_item(bf, lds, (int)((e >> 3) & 63u), (int)(e & 7u));
    }
}
#undef RESC
#undef ROW_RLI
#undef PK4
#undef KSWZ
#undef SBAR
}

__global__ void __launch_bounds__(256) naive_inproj(Bufs Bf) {
    __shared__ float hs[16][64];
    const int tid = threadIdx.x, dd = tid & 63, u = blockIdx.x * 4 + (tid >> 6), row0 = blockIdx.y * 16;
    const bool uv = u < 61;
    const int cb = !uv ? 0 : (u < 52 ? 128 * u : (u < 60 ? C_NZ + 128 * (u - 52) : C_NG));
    const bool v1ok = uv && (u < 60 || dd < 24), v2ok = uv && u < 60;
    const int c1 = cb + dd, c2 = cb + dd + 64;
    float a1[16], a2[16];
#pragma unroll
    for (int r = 0; r < 16; ++r) { a1[r] = 0.f; a2[r] = 0.f; }
    const bf16* H = Bf.b16(WS_H);
    for (int k0 = 0; k0 < 2048; k0 += 64) {
        __syncthreads();
        for (int i = tid; i < 16 * 64; i += 256) hs[i >> 6][i & 63] = bf2f(H[(size_t)(row0 + (i >> 6)) * 2048 + k0 + (i & 63)]);
        __syncthreads();
        for (int k = 0; k < 64; ++k) {
            const float w1 = v1ok ? Bf.w_in[(size_t)(k0 + k) * INC + c1] : 0.f, w2 = v2ok ? Bf.w_in[(size_t)(k0 + k) * INC + c2] : 0.f;
#pragma unroll
            for (int r = 0; r < 16; ++r) { const float h = hs[r][k]; a1[r] += h * w1; a2[r] += h * w2; }
        }
    }
    if (!uv) return;
    const float* COS = Bf.f32(WS_COS); const float* SIN = Bf.f32(WS_SIN);
    for (int r = 0; r < 16; ++r) {
        const int row = row0 + r, b = row >> 11, s = row & 2047; float v1 = a1[r], v2 = a2[r];
        bf16* dst = nullptr; int nh = 8, head = 0; bool rope = false; bf16* dst_raw = nullptr;
        if (u < 8) { dst = Bf.b16(WS_QM); head = u; rope = true; }
        else if (u < 16) { dst = Bf.b16(WS_KM); head = u - 8; rope = true; }
        else if (u < 24) { dst = Bf.b16(WS_VM); head = u - 16; }
        else if (u < 32) { bf16* gz = Bf.b16(WS_GZ) + (size_t)row * 2048 + (u - 24) * 128; gz[dd] = (bf16)f2bf(silu_f(v1)); gz[dd + 64] = (bf16)f2bf(silu_f(v2)); continue; }
        else if (u < 40) { dst = Bf.b16(WS_NQROT); dst_raw = Bf.b16(WS_NQRAW); head = u - 32; rope = true; }
        else if (u < 42) { dst = Bf.b16(WS_KCIN); head = u - 40; nh = 2; }
        else if (u < 44) { dst = Bf.b16(WS_VCIN); head = u - 42; nh = 2; }
        else if (u < 46) { dst = Bf.b16(WS_KS); head = u - 44; nh = 2; rope = true; }
        else if (u < 48) { dst = Bf.b16(WS_VS); head = u - 46; nh = 2; }
        else if (u < 50) { dst = Bf.b16(WS_KW); head = u - 48; nh = 2; rope = true; }
        else if (u < 52) { dst = Bf.b16(WS_VW); head = u - 50; nh = 2; }
        else if (u < 60) { bf16* gz = Bf.b16(WS_GZ) + (size_t)row * 2048 + 1024 + (u - 52) * 128; gz[dd] = (bf16)f2bf(silu_f(v1)); gz[dd + 64] = (bf16)f2bf(silu_f(v2)); continue; }
        else { if (dd < 24) Bf.f32(WS_GATES)[(size_t)row * 24 + dd] = sigmoid_f(v1); continue; }
        const size_t o = ((size_t)(b * nh + head) * SEQ + s) * HD + dd;
        if (dst_raw) { dst_raw[o] = (bf16)f2bf(v1); dst_raw[o + 64] = (bf16)f2bf(v2); }
        if (rope) { const float c = COS[(size_t)row * 64 + dd], sn = SIN[(size_t)row * 64 + dd]; const float o1 = v1 * c - v2 * sn, o2 = v2 * c + v1 * sn; v1 = o1; v2 = o2; }
        dst[o] = (bf16)f2bf(v1); dst[o + 64] = (bf16)f2bf(v2);
    }
}
__global__ void __launch_bounds__(256) naive_kmean(Bufs Bf) {
    const int i = blockIdx.x * 256 + threadIdx.x; if (i >= 8 * 8 * 8 * 128) return;
    const int d = i & 127, blk = (i >> 7) & 7, bh = i >> 10;
    const bf16* K = Bf.b16(WS_KM) + ((size_t)bh * SEQ + blk * 256) * HD + d; float s = 0.f;
    for (int r = 0; r < 256; ++r) s += bf2f(K[(size_t)r * HD]);
    Bf.f32(WS_KMS)[i] = s;
}
__global__ void __launch_bounds__(256) naive_compress(Bufs Bf) {
    __shared__ float in[4096]; __shared__ float hid[256];
    const int i = blockIdx.x, bg = blockIdx.y, kv = blockIdx.z, tid = threadIdx.x;
    bf16* outp = Bf.b16(kv ? WS_VC : WS_KC) + ((size_t)bg * 128 + i) * 128;
    if (i == 127) { if (tid < 128) outp[tid] = 0; return; }
    const bf16* src = Bf.b16(kv ? WS_VCIN : WS_KCIN) + ((size_t)bg * SEQ + 16 * i) * HD;
    const float* pe = kv ? Bf.pe_cv : Bf.pe_ck; const float* w1 = kv ? Bf.w_cv1 : Bf.w_ck1; const float* w2 = kv ? Bf.w_cv2 : Bf.w_ck2;
    for (int k = tid; k < 4096; k += 256) in[k] = bf2f(src[k]) + pe[k];
    __syncthreads();
    float a = 0.f;
    for (int k = 0; k < 4096; ++k) a += in[k] * w1[(size_t)k * 256 + tid];
    hid[tid] = silu_f(a);
    __syncthreads();
    if (tid < 128) { float o = 0.f; for (int n = 0; n < 256; ++n) o += hid[n] * w2[n * 128 + tid]; outp[tid] = (bf16)f2bf(o); }
}

#define WAVE_LDS_SYNC() asm volatile("s_waitcnt lgkmcnt(0)" ::: "memory")
__device__ __forceinline__ void na_load_q(const bf16* q, float* qf, int lane) { qf[lane] = bf2f(q[lane]); qf[lane + 64] = bf2f(q[lane + 64]); WAVE_LDS_SYNC(); }
__device__ __forceinline__ void na_scores(const float* qf, const bf16* K, int kb, bool valid, int lane, float* sc, int* kidx, int& n) {
    float s = -__builtin_inff();
    if (valid) { const bf16* kr = K + (size_t)(kb + lane) * HD; float a = 0.f;
        for (int d = 0; d < 128; d += 8) { const u32x4 w = *(const u32x4*)(kr + d);
            a += qf[d] * bf2f(w.x & 0xffffu) + qf[d + 1] * bf2f(w.x >> 16) + qf[d + 2] * bf2f(w.y & 0xffffu) + qf[d + 3] * bf2f(w.y >> 16)
               + qf[d + 4] * bf2f(w.z & 0xffffu) + qf[d + 5] * bf2f(w.z >> 16) + qf[d + 6] * bf2f(w.w & 0xffffu) + qf[d + 7] * bf2f(w.w >> 16); }
        s = a * SCALE; }
    sc[n + lane] = s; kidx[n + lane] = kb + lane; n += 64;
}
__device__ __forceinline__ float na_finish(float* sc, const int* kidx, int n, const bf16* V, int lane, float& o0, float& o1) {
    WAVE_LDS_SYNC();
    float m = -__builtin_inff();
    for (int i = lane; i < n; i += 64) m = fmaxf(m, sc[i]);
    m = wave_max(m);
    if (m == -__builtin_inff()) { o0 = 0.f; o1 = 0.f; return 0.f; }
    float l = 0.f;
    for (int i = lane; i < n; i += 64) { const float p = __expf(sc[i] - m); sc[i] = p; l += p; }
    l = wave_sum(l);
    WAVE_LDS_SYNC();
    float a0 = 0.f, a1 = 0.f;
    for (int i = 0; i < n; ++i) { const float p = sc[i]; if (p != 0.f) { const bf16* vr = V + (size_t)kidx[i] * HD; a0 += p * bf2f(vr[lane]); a1 += p * bf2f(vr[lane + 64]); } }
    const float rl = 1.f / l; o0 = a0 * rl; o1 = a1 * rl; return l;
}
__global__ void __launch_bounds__(256) naive_moba(Bufs Bf) {
    __shared__ float sc_[4][1024]; __shared__ int kx_[4][1024]; __shared__ float qf_[4][128];
    const int w = threadIdx.x >> 6, lane = threadIdx.x & 63;
    const int q = blockIdx.x * 4 + w, bh = blockIdx.y, b = bh >> 3, h = bh & 7;
    float* sc = sc_[w]; int* kidx = kx_[w]; float* qf = qf_[w];
    const bf16* Q = Bf.b16(WS_QM) + ((size_t)bh * SEQ + q) * HD; const bf16* K = Bf.b16(WS_KM) + (size_t)bh * SEQ * HD; const bf16* V = Bf.b16(WS_VM) + (size_t)bh * SEQ * HD;
    na_load_q(Q, qf, lane);
    const int own = q >> 8;
    float g = -__builtin_inff();
    if (lane < own) { const float* km = Bf.f32(WS_KMS) + ((size_t)bh * 8 + lane) * 128; float a = 0.f; for (int d = 0; d < 128; ++d) a += qf[d] * km[d]; g = a; }
    int rank = 0;
    for (int k = 0; k < 8; ++k) { const float gk = __shfl(g, k); rank += (gk > g || (gk == g && k < lane)) ? 1 : 0; }
    const bool sel = (lane < own) && rank < 3;
    const unsigned long long selm = __ballot(sel);
    int n = 0;
    for (int j = 0; j < own; ++j) if ((selm >> j) & 1ull) for (int c = 0; c < 4; ++c) na_scores(qf, K, j * 256 + c * 64, true, lane, sc, kidx, n);
    for (int c = 0; c < 4; ++c) { const int kb = own * 256 + c * 64; if (kb <= q) na_scores(qf, K, kb, kb + lane <= q, lane, sc, kidx, n); }
    float o0, o1; na_finish(sc, kidx, n, V, lane, o0, o1);
    const int row = b * SEQ + q; const bf16* gz = Bf.b16(WS_GZ) + (size_t)row * 2048 + h * 128; bf16* T = Bf.b16(WS_T) + (size_t)row * 2048 + h * 128;
    T[lane] = (bf16)f2bf(o0 * bf2f(gz[lane])); T[lane + 64] = (bf16)f2bf(o1 * bf2f(gz[lane + 64]));
}
__global__ void __launch_bounds__(128) naive_nsa(Bufs Bf) {
    __shared__ float sc_[2][640]; __shared__ int kx_[2][640]; __shared__ float qf_[2][128];
    const int w = threadIdx.x >> 6, lane = threadIdx.x & 63;
    const int q = blockIdx.x * 2 + w, bg = blockIdx.y, b = bg >> 1, g = bg & 1;
    float* sc = sc_[w]; int* kidx = kx_[w]; float* qf = qf_[w];
    const int row = b * SEQ + q, own = q >> 6;
    const bf16* KC = Bf.b16(WS_KC) + (size_t)bg * 128 * HD; const bf16* VC = Bf.b16(WS_VC) + (size_t)bg * 128 * HD;
    const bf16* KS = Bf.b16(WS_KS) + (size_t)bg * SEQ * HD; const bf16* VS = Bf.b16(WS_VS) + (size_t)bg * SEQ * HD;
    const bf16* KW = Bf.b16(WS_KW) + (size_t)bg * SEQ * HD; const bf16* VW = Bf.b16(WS_VW) + (size_t)bg * SEQ * HD;
    float oc0[4], oc1[4]; float imp = 0.f;
    for (int r = 0; r < 4; ++r) {
        const int head = g * 4 + r;
        na_load_q(Bf.b16(WS_NQRAW) + ((size_t)(b * 8 + head) * SEQ + q) * HD, qf, lane);
        int n = 0;
        for (int c = 0; c < 2; ++c) { const int key = c * 64 + lane; na_scores(qf, KC, c * 64, key < 127 && 16 * key + 31 <= q, lane, sc, kidx, n); }
        const float l = na_finish(sc, kidx, n, VC, lane, oc0[r], oc1[r]);
        if (l > 0.f && lane < 32) { const float rl = 1.f / l; float a = 0.f;
            for (int t = 4 * lane - 1; t <= 4 * lane + 3; ++t) if (t >= 0 && t < 127) a += sc[t] * rl;
            imp += a; }
        WAVE_LDS_SYNC();
    }
    float s = -__builtin_inff();
    if (lane < 32) { if (lane > own) s = -__builtin_inff(); else if (lane == 0 || lane == own || lane == own - 1) s = __builtin_inff(); else s = imp; }
    int rank = 0;
    for (int k = 0; k < 32; ++k) { const float sk = __shfl(s, k); rank += (sk > s || (sk == s && k < lane)) ? 1 : 0; }
    const bool sel = lane < 32 && rank < 8 && s > -__builtin_inff();
    const unsigned long long selm = __ballot(sel);
    const float* gt = Bf.f32(WS_GATES) + (size_t)row * 24 + g * 12;
    for (int r = 0; r < 4; ++r) {
        const int head = g * 4 + r;
        na_load_q(Bf.b16(WS_NQROT) + ((size_t)(b * 8 + head) * SEQ + q) * HD, qf, lane);
        int n = 0;
        for (int j = 0; j < 32; ++j) if ((selm >> j) & 1ull) na_scores(qf, KS, j * 64, j * 64 + lane <= q, lane, sc, kidx, n);
        float os0, os1; na_finish(sc, kidx, n, VS, lane, os0, os1);
        WAVE_LDS_SYNC();
        n = 0;
        const int lo = q - 511 > 0 ? q - 511 : 0;
        for (int kb = (lo >> 6) << 6; kb <= q; kb += 64) { const int key = kb + lane; na_scores(qf, KW, kb, key <= q && key > q - 512, lane, sc, kidx, n); }
        float ow0, ow1; na_finish(sc, kidx, n, VW, lane, ow0, ow1);
        WAVE_LDS_SYNC();
        const float g0 = gt[r * 3 + 0], g1 = gt[r * 3 + 1], g2 = gt[r * 3 + 2];
        const float v0 = g0 * oc0[r] + g1 * os0 + g2 * ow0, v1 = g0 * oc1[r] + g1 * os1 + g2 * ow1;
        const bf16* gz = Bf.b16(WS_GZ) + (size_t)row * 2048 + 1024 + head * 128; bf16* T = Bf.b16(WS_T) + (size_t)row * 2048 + 1024 + head * 128;
        T[lane] = (bf16)f2bf(v0 * bf2f(gz[lane])); T[lane + 64] = (bf16)f2bf(v1 * bf2f(gz[lane + 64]));
    }
}
__global__ void __launch_bounds__(256) naive_tnorm(Bufs Bf) {
    const int lane = threadIdx.x & 63, row = blockIdx.x * 4 + (threadIdx.x >> 6);
    bf16* T = Bf.b16(WS_T) + (size_t)row * 2048;
    for (int half = 0; half < 2; ++half) {
        bf16* p = T + half * 1024 + lane * 16; u32x4 a = *(u32x4*)p, c = *(u32x4*)(p + 8); unsigned w[8] = {a.x, a.y, a.z, a.w, c.x, c.y, c.z, c.w};
        float s = 0.f;
#pragma unroll
        for (int i = 0; i < 8; ++i) { const float lo = bf2f(w[i] & 0xffffu), hi = bf2f(w[i] >> 16); s += lo * lo + hi * hi; }
        const float rstd = 1.0f / sqrtf(wave_sum(s) * (1.f / 1024.f) + EPS);
#pragma unroll
        for (int i = 0; i < 8; ++i) w[i] = pk2(bf2f(w[i] & 0xffffu) * rstd, bf2f(w[i] >> 16) * rstd);
        *(u32x4*)p = (u32x4){w[0], w[1], w[2], w[3]}; *(u32x4*)(p + 8) = (u32x4){w[4], w[5], w[6], w[7]};
    }
}
__global__ void __launch_bounds__(256) naive_outproj(Bufs Bf) {
    __shared__ float ys[16][64];
    const int tid = threadIdx.x, col = blockIdx.x * 256 + tid, row0 = blockIdx.y * 16;
    float a[16];
#pragma unroll
    for (int r = 0; r < 16; ++r) a[r] = 0.f;
    const bf16* T = Bf.b16(WS_T);
    for (int k0 = 0; k0 < 2048; k0 += 64) {
        __syncthreads();
        for (int i = tid; i < 16 * 64; i += 256) ys[i >> 6][i & 63] = bf2f(T[(size_t)(row0 + (i >> 6)) * 2048 + k0 + (i & 63)]);
        __syncthreads();
        for (int k = 0; k < 64; ++k) { const int e = k0 + k; const float w = Bf.w_out[(size_t)e * 2048 + col] * (e < 1024 ? Bf.g_out_moba[e] : Bf.g_out_nsa[e - 1024]);
#pragma unroll
            for (int r = 0; r < 16; ++r) a[r] += ys[r][k] * w; }
    }
    for (int r = 0; r < 16; ++r) { const size_t o = (size_t)(row0 + r) * 2048 + col; Bf.out[o] = Bf.x[o] + a[r]; }
}
__device__ __forceinline__ void final_norm_row(const Bufs& Bf, int m, int lane) {
    float* xr = Bf.out + (size_t)m * DM + lane * 8; f32x4 v[8]; float s = 0.f;
#pragma unroll
    for (int j = 0; j < 4; ++j) { v[2 * j] = *(const f32x4*)(xr + j * 512); v[2 * j + 1] = *(const f32x4*)(xr + j * 512 + 4); }
#pragma unroll
    for (int j = 0; j < 8; ++j) s += (v[j].x * v[j].x + v[j].y * v[j].y) + (v[j].z * v[j].z + v[j].w * v[j].w);
    const float rstd = 1.0f / sqrtf(wave_sum(s) * (1.f / DM) + EPS);
#pragma unroll
    for (int j = 0; j < 4; ++j) { const f32x4 g0 = *(const f32x4*)(Bf.g_final + j * 512 + lane * 8), g1 = *(const f32x4*)(Bf.g_final + j * 512 + lane * 8 + 4);
        *(f32x4*)(xr + j * 512) = v[2 * j] * rstd * g0; *(f32x4*)(xr + j * 512 + 4) = v[2 * j + 1] * rstd * g1; }
}
__global__ void __launch_bounds__(256) naive_final(Bufs Bf) { final_norm_row(Bf, blockIdx.x * 4 + (threadIdx.x >> 6), threadIdx.x & 63); }

#define LAS __attribute__((address_space(3)))
#define XB_TMO      128
#define XB_XCNT(j)  (256  + 64 * (j))
#define XB_XSUB(j)  (1280 + 64 * (j))
#define XB_XGEN(j)  (2304 + 64 * (j))
#define XB_TOP      3328
#define XB_TOPGEN   3392
#define XCD_BAR_WORDS 3456
#define XB_SPIN_CAP (1u << 18)

__device__ __forceinline__ unsigned xb_ld(unsigned* p)              { return __hip_atomic_load(p, __ATOMIC_RELAXED, __HIP_MEMORY_SCOPE_AGENT); }
__device__ __forceinline__ unsigned xb_add(unsigned* p, unsigned v) { return __hip_atomic_fetch_add(p, v, __ATOMIC_RELAXED, __HIP_MEMORY_SCOPE_AGENT); }
__device__ __forceinline__ unsigned xb_xcc_id() { return (unsigned)__builtin_amdgcn_s_getreg((3 << 11) | 20) & 0xFu; }
#define XB_SPIN(cond, bar) do { unsigned _sp = 0; while (cond) { __builtin_amdgcn_s_sleep(1); \
    if ((++_sp & 255u) == 0u) { if (xb_ld(&(bar)[XB_TMO])) break; if (_sp > XB_SPIN_CAP) { atomicAdd(&(bar)[XB_TMO], 1u); break; } } } } while (0)

struct XcdBarrier {
    unsigned* bar; unsigned x;
    volatile LAS unsigned* st;
};

__device__ __forceinline__ XcdBarrier xcd_barrier_post(unsigned* bar, volatile LAS unsigned* st) {
    XcdBarrier b; b.bar = bar; b.x = xb_xcc_id(); b.st = st;
    if (threadIdx.x == 0) (void)xb_add(&bar[XB_XCNT(b.x)], 1u);
    return b;
}
__device__ __forceinline__ void xcd_barrier_complete(unsigned* bar, unsigned x, unsigned& nloc, unsigned& nx) {
    const unsigned G = gridDim.x * gridDim.y * gridDim.z;
    unsigned sum, cnt, mine, sp = 0u;
    for (;;) {
        sum = 0u; cnt = 0u; mine = 0u;
#pragma unroll
        for (unsigned j = 0; j < 16; ++j) { const unsigned c = xb_ld(&bar[XB_XCNT(j)]); sum += c; cnt += (c > 0u) ? 1u : 0u; mine = (j == x) ? c : mine; }
        if (sum == G) break;
        __builtin_amdgcn_s_sleep(1);
        if ((++sp & 255u) == 0u) { if (xb_ld(&bar[XB_TMO])) break; if (sp > XB_SPIN_CAP) { atomicAdd(&bar[XB_TMO], 1u); break; } }
    }
    nloc = mine > 0u ? mine : 1u; nx = cnt > 0u ? cnt : 1u;
}

__device__ __forceinline__ void xcd_barrier(const XcdBarrier& b) {
    asm volatile("s_waitcnt vmcnt(0)" ::: "memory");
    __syncthreads();
    if (threadIdx.x == 0) {
        unsigned* bar = b.bar;
        __builtin_amdgcn_s_waitcnt(0);
        unsigned nloc = b.st[0], nx = b.st[1];
        if (nloc == 0u) { xcd_barrier_complete(bar, b.x, nloc, nx); b.st[0] = nloc; b.st[1] = nx; }
        const unsigned old = xb_add(&bar[XB_XSUB(b.x)], 1u);
        const unsigned gen = old / nloc;
        if (old + 1u == (gen + 1u) * nloc) {
            __builtin_amdgcn_fence(__ATOMIC_RELEASE, "agent");
            asm volatile("s_waitcnt vmcnt(0)" ::: "memory");
            const unsigned og = xb_add(&bar[XB_TOP], 1u);
            const unsigned tg = og / nx;
            if (og + 1u == (tg + 1u) * nx) xb_add(&bar[XB_TOPGEN], 1u);
            else XB_SPIN(xb_ld(&bar[XB_TOPGEN]) == tg, bar);
            __builtin_amdgcn_fence(__ATOMIC_ACQUIRE, "agent");
            xb_add(&bar[XB_XGEN(b.x)], 1u);
            asm volatile("s_waitcnt vmcnt(0)" ::: "memory");
        } else {
            XB_SPIN(xb_ld(&bar[XB_XGEN(b.x)]) == gen, bar);
            __builtin_amdgcn_fence(__ATOMIC_ACQUIRE, "agent");
            asm volatile("s_waitcnt vmcnt(0)" ::: "memory");
        }
    }
    __syncthreads();
}

constexpr int L_HID = 0;
__device__ __forceinline__ void compress_phase(const Bufs& bf, char* lds, int wg, int G) {
    const int tid = att::opaque_tid(), lane = tid & 63, wid = __builtin_amdgcn_readfirstlane(tid >> 6), l15 = lane & 15, l4 = lane >> 4;
    bf16* hidb = (bf16*)(lds + L_HID);
    for (int it = wg; it < 256; it += G) {
        const int kv = it >> 7, bg = (it >> 3) & 15, mc = it & 7;
        const bf16* src = bf.b16(kv ? WS_VCIN : WS_KCIN) + (size_t)bg * SEQ * HD;
        int i = 16 * mc + l15; if (i > 126) i = 126;
        const bf16* arow = src + (size_t)i * 2048 + l4 * 8;
        const bf16* b0p = bf.b16(WS_WC1T) + (size_t)kv * 256 * 4096 + ((size_t)(2 * wid) * 128 * 64 + lane) * 8; const bf16* b1p = b0p + 128 * 64 * 8;
        f32x4 acc0 = {0.f, 0.f, 0.f, 0.f}, acc1 = acc0;
#pragma unroll 8
        for (int ks = 0; ks < 128; ++ks) {
            const bf16x8 a = *(const bf16x8*)(arow + 32 * ks), b0 = *(const bf16x8*)(b0p + 512 * ks), b1 = *(const bf16x8*)(b1p + 512 * ks);
            acc0 = __builtin_amdgcn_mfma_f32_16x16x32_bf16(a, b0, acc0, 0, 0, 0); acc1 = __builtin_amdgcn_mfma_f32_16x16x32_bf16(a, b1, acc1, 0, 0, 0); }
        const float* cb = bf.f32(WS_CBIAS) + (size_t)kv * 64 * 256 + 32 * wid + l15; float bias0 = 0.f, bias1 = 0.f;
        for (int c = 0; c < 64; ++c) { bias0 += cb[c * 256]; bias1 += cb[c * 256 + 16]; }
#pragma unroll
        for (int r = 0; r < 4; ++r) { const int row = 4 * l4 + r;
            hidb[row * 264 + 32 * wid + l15] = (bf16)f2bf(silu_f(acc0[r] + bias0)); hidb[row * 264 + 32 * wid + 16 + l15] = (bf16)f2bf(silu_f(acc1[r] + bias1)); }
        __syncthreads();
        const bf16* w2p = bf.b16(WS_WC2T) + (size_t)kv * 128 * 256 + (size_t)(16 * wid + l15) * 256 + l4 * 8;
        f32x4 oacc = {0.f, 0.f, 0.f, 0.f};
#pragma unroll
        for (int ks = 0; ks < 8; ++ks) { const bf16x8 a = *(const bf16x8*)(hidb + l15 * 264 + 32 * ks + 8 * l4), bb = *(const bf16x8*)(w2p + 32 * ks);
            oacc = __builtin_amdgcn_mfma_f32_16x16x32_bf16(a, bb, oacc, 0, 0, 0); }
        bf16* outp = bf.b16(kv ? WS_VC : WS_KC) + (size_t)bg * 128 * HD + 16 * wid + l15;
#pragma unroll
        for (int r = 0; r < 4; ++r) { const int io = 16 * mc + 4 * l4 + r; outp[(size_t)io * HD] = io == 127 ? (bf16)0 : (bf16)f2bf(oacc[r]); }
        __syncthreads();
    }
}
__device__ __forceinline__ void tnorm_row(const Bufs& bf, int row, int lane) {
    bf16* T = bf.b16(WS_T) + (size_t)row * 2048;
#pragma unroll
    for (int half = 0; half < 2; ++half) {
        bf16* p = T + half * 1024 + lane * 16; const u32x4 a = *(u32x4*)p, c = *(u32x4*)(p + 8); unsigned w[8] = {a.x, a.y, a.z, a.w, c.x, c.y, c.z, c.w};
        float s = 0.f;
#pragma unroll
        for (int i = 0; i < 8; ++i) { const float lo = bf2f(w[i] & 0xffffu), hi = bf2f(w[i] >> 16); s += lo * lo + hi * hi; }
        const float rstd = 1.0f / sqrtf(wave_sum(s) * (1.f / 1024.f) + EPS);
#pragma unroll
        for (int i = 0; i < 8; ++i) w[i] = pk2(bf2f(w[i] & 0xffffu) * rstd, bf2f(w[i] >> 16) * rstd);
        *(u32x4*)p = (u32x4){w[0], w[1], w[2], w[3]}; *(u32x4*)(p + 8) = (u32x4){w[4], w[5], w[6], w[7]};
    }
}

constexpr int NWAVES = 8;
constexpr int LDS_BYTES = 147456;
constexpr int L_MISC = 139264;
constexpr int CW_BAR = 4096;
struct Args { Bufs bf; int ph_lo, ph_hi; };
__global__ void __launch_bounds__(NWAVES * 64, 2) mk_fwd(Args args) {
    extern __shared__ __attribute__((aligned(16))) unsigned char lds[];
    const int tid = threadIdx.x, lane = tid & 63, wave = __builtin_amdgcn_readfirstlane(tid >> 6);
    const int G = gridDim.x, gw = blockIdx.x * NWAVES + wave, NGW = G * NWAVES;
    const int lo = args.ph_lo, hi = args.ph_hi;
    volatile LAS unsigned* MISC = (volatile LAS unsigned*)((LAS unsigned char*)lds + L_MISC);
    if (tid < 16) MISC[tid] = 0u;
    __syncthreads();
    unsigned* ctl = (unsigned*)(args.bf.ws + WS_CTL);
    XcdBarrier bar; bar.bar = ctl + CW_BAR; bar.x = 0; bar.st = nullptr;
    if (hi - lo > 1) bar = xcd_barrier_post(ctl + CW_BAR, MISC + 8);
#define IN(k) (lo <= (k) && (k) < hi)
#define SEAM(k) do { if (IN(k) && IN((k) + 1)) xcd_barrier(bar); } while (0)
    if (IN(0)) p0_prologue(args.bf, gw, NGW, lane, (float*)(lds + wave * 16384));
#if defined(PROBE_DUP) && PROBE_DUP == 0
    xcd_barrier(bar); p0_prologue(args.bf, gw, NGW, lane, (float*)(lds + wave * 16384));
#endif
    SEAM(0);
    if (IN(1)) {
        pg8::Gemm g{args.bf.b16(WS_H), args.bf.b16(WS_WINT), M, NPAD, 2048}; pg8::StaticOrder S; S.init(M, NPAD, G, (int)blockIdx.x);
        EpiIn E{args.bf};
        pg8::gemm_phase<EpiIn, pg8::StaticOrder, true, true>((PG8_LAS unsigned char*)lds, g, S, E);
    }
#if defined(PROBE_DUP) && PROBE_DUP == 1
    xcd_barrier(bar);
    {   pg8::Gemm g{args.bf.b16(WS_H), args.bf.b16(WS_WINT), M, NPAD, 2048}; pg8::StaticOrder S; S.init(M, NPAD, G, (int)blockIdx.x);
        EpiIn E{args.bf};
        pg8::gemm_phase<EpiIn, pg8::StaticOrder, true, true>((PG8_LAS unsigned char*)lds, g, S, E); }
#endif
    SEAM(1);
    if (IN(2)) compress_phase(args.bf, (char*)lds, (int)blockIdx.x, G);
#if defined(PROBE_DUP) && PROBE_DUP == 2
    xcd_barrier(bar); compress_phase(args.bf, (char*)lds, (int)blockIdx.x, G);
#endif
    SEAM(2);
    if (IN(3)) att::attn_phase(args.bf, (char*)lds);
#if defined(PROBE_DUP) && PROBE_DUP == 3
    xcd_barrier(bar); att::attn_phase(args.bf, (char*)lds, 128);
#endif
    SEAM(3);
    if (IN(4)) for (int m = gw; m < M; m += NGW) tnorm_row(args.bf, m, lane);
#if defined(PROBE_DUP) && PROBE_DUP == 4
    xcd_barrier(bar); for (int m = gw; m < M; m += NGW) tnorm_row(args.bf, m, lane);
#endif
    SEAM(4);
    if (IN(5)) {
        pg8::Gemm g{args.bf.b16(WS_T), args.bf.b16(WS_WOUTT), M, DM, 2048}; pg8::StaticOrder S; S.init(M, DM, G, (int)blockIdx.x);
        EpiOut E{args.bf.x, args.bf.out};
        pg8::gemm_phase<EpiOut, pg8::StaticOrder, true, true>((PG8_LAS unsigned char*)lds, g, S, E);
    }
    SEAM(5);
    if (IN(6)) for (int m = gw; m < M; m += NGW) final_norm_row(args.bf, m, lane);
#if defined(PROBE_DUP) && PROBE_DUP == 6
    xcd_barrier(bar); for (int m = gw; m < M; m += NGW) final_norm_row(args.bf, m, lane);
#endif
#undef IN
#undef SEAM
}

extern "C" void kernel_launch(void* const* d_in, const int* in_sizes, int n_in, void* d_out, int out_size, void* d_ws, size_t ws_size, hipStream_t stream) {
    static int grid = 0;
    if (grid == 0) {
        if (n_in != 14 || in_sizes[0] != M * DM || out_size != M * DM || ws_size < WS_END) {
            fprintf(stderr, "kernel_launch: unexpected shapes: n_in %d in0 %d out %d ws %zu (need %zu)\n", n_in, n_in > 0 ? in_sizes[0] : -1, out_size, ws_size, (size_t)WS_END); grid = -1; return; }
        int dev = 0, cus = 0;
        if (hipGetDevice(&dev) != hipSuccess || hipDeviceGetAttribute(&cus, hipDeviceAttributeMultiprocessorCount, dev) != hipSuccess) { grid = -1; return; }
        if (hipFuncSetAttribute((const void*)mk_fwd, hipFuncAttributeMaxDynamicSharedMemorySize, LDS_BYTES) != hipSuccess) { fprintf(stderr, "kernel_launch: hipFuncSetAttribute failed\n"); grid = -1; return; }
        grid = cus;
    }
    if (grid < 0) return;
    (void)hipMemsetAsync((char*)d_ws + WS_CTL, 0, CTL_ZERO_BYTES, stream);
    Args a{};
    a.bf.x = (const float*)d_in[0]; a.bf.pos = (const int*)d_in[1]; a.bf.w_in = (const float*)d_in[2]; a.bf.g_norm = (const float*)d_in[3];
    a.bf.pe_ck = (const float*)d_in[4]; a.bf.pe_cv = (const float*)d_in[5]; a.bf.w_ck1 = (const float*)d_in[6]; a.bf.w_ck2 = (const float*)d_in[7];
    a.bf.w_cv1 = (const float*)d_in[8]; a.bf.w_cv2 = (const float*)d_in[9]; a.bf.g_out_moba = (const float*)d_in[10]; a.bf.g_out_nsa = (const float*)d_in[11];
    a.bf.w_out = (const float*)d_in[12]; a.bf.g_final = (const float*)d_in[13]; a.bf.out = (float*)d_out; a.bf.ws = (unsigned char*)d_ws;
#ifndef MK_N_LAUNCHES
#define MK_N_LAUNCHES 1
#endif
    if (MK_N_LAUNCHES == 1) { a.ph_lo = 0; a.ph_hi = 7; hipLaunchKernelGGL(mk_fwd, dim3(grid), dim3(NWAVES * 64), LDS_BYTES, stream, a); }
    else for (int ph = 0; ph < 7; ++ph) { a.ph_lo = ph; a.ph_hi = ph + 1; hipLaunchKernelGGL(mk_fwd, dim3(grid), dim3(NWAVES * 64), LDS_BYTES, stream, a); }
}
```
